# Optimizing an MI355X kernel written in HIP

```python
import jax, jax.numpy as jnp
from jax import lax
import numpy as np

D_MODEL = 1024
BATCH = 1
SEQ = 16384
DEPTH = 1
DEC_BATCH = 8
DEC_SEQ = 4096
PAST_LEN = 128

N_FOURIER_GROUPS = 4
FOURIER_GROUP_DIM = 128
FOURIER_WIDTH = N_FOURIER_GROUPS * FOURIER_GROUP_DIM
N_HEADS = 8
QK_NOPE_DIM = 64
QK_ROPE_DIM = 32
QK_HEAD_DIM = QK_NOPE_DIM + QK_ROPE_DIM
V_HEAD_DIM = 64
ATTN_WIDTH = N_HEADS * V_HEAD_DIM
Q_LORA_RANK = 384
KV_LORA_RANK = 256
ROPE_THETA = 10000.0
Q_BLOCK = 128
N_BRANCHES = 2
D_FF = -(-8 * D_MODEL // (3 * 256)) * 256
LN_EPS = 1e-5
RMS_EPS = 1e-6
DEEPNORM_ALPHA = (2.0 * DEPTH) ** 0.25
DEEPNORM_BETA = (8.0 * DEPTH) ** -0.25
IN_PROJ_DIM = FOURIER_WIDTH + Q_LORA_RANK + KV_LORA_RANK + QK_ROPE_DIM + N_BRANCHES * D_MODEL

kernel_name = "fnet_mla_gated_deepnorm_encoder"


def layer_norm(x, g, b):
    xf = x.astype(jnp.float32)
    mu = jnp.mean(xf, axis=-1, keepdims=True)
    var = jnp.mean(jnp.square(xf - mu), axis=-1, keepdims=True)
    y = (xf - mu) * lax.rsqrt(var + LN_EPS) * g.astype(jnp.float32) + b.astype(jnp.float32)
    return y.astype(x.dtype)


def rms_norm(x, g):
    xf = x.astype(jnp.float32)
    y = xf * lax.rsqrt(jnp.mean(jnp.square(xf), axis=-1, keepdims=True) + RMS_EPS) * g.astype(jnp.float32)
    return y.astype(x.dtype)


def rope(x, seq_len):
    half = QK_ROPE_DIM // 2
    inv_freq = 1.0 / (ROPE_THETA ** (jnp.arange(0, QK_ROPE_DIM, 2, dtype=jnp.float32) / QK_ROPE_DIM))
    ang = jnp.arange(seq_len, dtype=jnp.float32)[:, None] * inv_freq[None, :]
    cos = jnp.cos(ang)[None, :, None, :].astype(x.dtype)
    sin = jnp.sin(ang)[None, :, None, :].astype(x.dtype)
    x1, x2 = x[..., :half], x[..., half:]
    return jnp.concatenate([x1 * cos - x2 * sin, x2 * cos + x1 * sin], axis=-1)


def fourier_mix(u):
    b, s, _ = u.shape
    ug = u.astype(jnp.float32).reshape(b, s, N_FOURIER_GROUPS, FOURIER_GROUP_DIM)
    f = jnp.fft.fft2(ug, axes=(1, 3), norm="ortho").real
    return f.reshape(b, s, FOURIER_WIDTH).astype(u.dtype)


def mla_attention(c_q, c_kv, k_rope, g_q, w_uq, g_kv, w_ukv):
    b, s, _ = c_q.shape
    q = (rms_norm(c_q, g_q) @ w_uq).reshape(b, s, N_HEADS, QK_HEAD_DIM)
    q = jnp.concatenate([q[..., :QK_NOPE_DIM], rope(q[..., QK_NOPE_DIM:], s)], axis=-1)
    kv = (rms_norm(c_kv, g_kv) @ w_ukv).reshape(b, s, N_HEADS, QK_NOPE_DIM + V_HEAD_DIM)
    k_nope, v = kv[..., :QK_NOPE_DIM], kv[..., QK_NOPE_DIM:]
    k_pe = rope(k_rope[:, :, None, :], s)
    k = jnp.concatenate([k_nope, jnp.broadcast_to(k_pe, (b, s, N_HEADS, QK_ROPE_DIM))], axis=-1)
    scale = QK_HEAD_DIM ** -0.5
    n_blk = s // Q_BLOCK
    q_blocks = q.reshape(b, n_blk, Q_BLOCK, N_HEADS, QK_HEAD_DIM).transpose(1, 0, 2, 3, 4)

    def attend(qb):
        sc = jnp.einsum('bqhd,bkhd->bhqk', qb, k, preferred_element_type=jnp.float32) * scale
        p = jax.nn.softmax(sc, axis=-1).astype(v.dtype)
        return jnp.einsum('bhqk,bkhd->bqhd', p, v)

    o = lax.map(attend, q_blocks)
    return o.transpose(1, 0, 2, 3, 4).reshape(b, s, ATTN_WIDTH)


def encoder_layer(x, w_in, w_fourier, g_q, w_uq, g_kv, w_ukv, w_attn, w_o,
                  ln1_g, ln1_b, w_gate, w_up, w_down, ln2_g, ln2_b):
    b, s, _ = x.shape
    proj = x @ w_in
    o0 = FOURIER_WIDTH
    o1 = o0 + Q_LORA_RANK
    o2 = o1 + KV_LORA_RANK
    o3 = o2 + QK_ROPE_DIM
    u_f, c_q, c_kv, k_rope, gates = proj[..., :o0], proj[..., o0:o1], proj[..., o1:o2], proj[..., o2:o3], proj[..., o3:]
    branch_a = fourier_mix(u_f) @ w_fourier
    branch_b = mla_attention(c_q, c_kv, k_rope, g_q, w_uq, g_kv, w_ukv) @ w_attn
    g = jax.nn.sigmoid(gates.astype(jnp.float32)).astype(x.dtype).reshape(b, s, N_BRANCHES, D_MODEL)
    merged = g[:, :, 0] * branch_a + g[:, :, 1] * branch_b
    h = layer_norm(DEEPNORM_ALPHA * x + merged @ w_o, ln1_g, ln1_b)
    ffn = (jax.nn.silu(h @ w_gate) * (h @ w_up)) @ w_down
    return layer_norm(DEEPNORM_ALPHA * h + ffn, ln2_g, ln2_b)


def setup_inputs(seed: int = 0) -> dict:
    key = jax.random.key(seed)
    ks = jax.random.split(key, 18)
    f32 = jnp.float32

    def w(k, shape, fan_in, mult=1.0):
        return jax.random.normal(k, (DEPTH,) + shape, f32) * (fan_in ** -0.5) * mult

    def gain(k, n):
        return 1.0 + 0.02 * jax.random.normal(k, (DEPTH, n), f32)

    def bias(k, n):
        return 0.02 * jax.random.normal(k, (DEPTH, n), f32)

    return {
        "x_prompt": jax.random.normal(ks[0], (BATCH, SEQ, D_MODEL), f32),
        "x_sample": jax.random.normal(ks[1], (DEC_BATCH, DEC_SEQ, D_MODEL), f32),
        "w_in": w(ks[2], (D_MODEL, IN_PROJ_DIM), D_MODEL),
        "w_fourier": w(ks[3], (FOURIER_WIDTH, D_MODEL), FOURIER_WIDTH),
        "g_q": gain(ks[4], Q_LORA_RANK),
        "w_uq": w(ks[5], (Q_LORA_RANK, N_HEADS * QK_HEAD_DIM), Q_LORA_RANK),
        "g_kv": gain(ks[6], KV_LORA_RANK),
        "w_ukv": w(ks[7], (KV_LORA_RANK, N_HEADS * (QK_NOPE_DIM + V_HEAD_DIM)), KV_LORA_RANK),
        "w_attn": w(ks[8], (ATTN_WIDTH, D_MODEL), ATTN_WIDTH),
        "w_o": w(ks[9], (D_MODEL, D_MODEL), D_MODEL, DEEPNORM_BETA),
        "ln1_g": gain(ks[10], D_MODEL),
        "ln1_b": bias(ks[11], D_MODEL),
        "w_gate": w(ks[12], (D_MODEL, D_FF), D_MODEL),
        "w_up": w(ks[13], (D_MODEL, D_FF), D_MODEL),
        "w_down": w(ks[14], (D_FF, D_MODEL), D_FF, DEEPNORM_BETA),
        "ln2_g": gain(ks[15], D_MODEL),
        "ln2_b": bias(ks[16], D_MODEL),
    }


def _trunk(x, w_in, w_fourier, g_q, w_uq, g_kv, w_ukv, w_attn, w_o,
           ln1_g, ln1_b, w_gate, w_up, w_down, ln2_g, ln2_b):
    for l in range(DEPTH):
        x = encoder_layer(x, w_in[l], w_fourier[l], g_q[l], w_uq[l], g_kv[l], w_ukv[l], w_attn[l], w_o[l],
                          ln1_g[l], ln1_b[l], w_gate[l], w_up[l], w_down[l], ln2_g[l], ln2_b[l])
    return x


def reference(x_prompt, x_sample, w_in, w_fourier, g_q, w_uq, g_kv, w_ukv, w_attn, w_o,
              ln1_g, ln1_b, w_gate, w_up, w_down, ln2_g, ln2_b):
    y_prompt = _trunk(x_prompt, w_in, w_fourier, g_q, w_uq, g_kv, w_ukv, w_attn, w_o,
                      ln1_g, ln1_b, w_gate, w_up, w_down, ln2_g, ln2_b)
    y_sample = _trunk(x_sample, w_in, w_fourier, g_q, w_uq, g_kv, w_ukv, w_attn, w_o,
                      ln1_g, ln1_b, w_gate, w_up, w_down, ln2_g, ln2_b)
    return (y_prompt, y_sample)
```

```cpp
#include <hip/hip_runtime.h>
#include <hip/hip_cooperative_groups.h>
#include <stdint.h>
#include <stdio.h>
namespace cg = cooperative_groups;

#ifndef COOP
#define COOP 1
#endif

#define LAS __attribute__((address_space(3)))
typedef unsigned short bf16_t;
typedef short bf16x8 __attribute__((ext_vector_type(8)));
typedef float f32x16 __attribute__((ext_vector_type(16)));
typedef float f32x4 __attribute__((ext_vector_type(4)));
typedef float f32x2 __attribute__((ext_vector_type(2)));
typedef unsigned u32x4 __attribute__((ext_vector_type(4)));
typedef unsigned u32x2 __attribute__((ext_vector_type(2)));

constexpr int T = 49152, TP = 16384;
constexpr size_t MiB = (size_t)1 << 20;
constexpr size_t OFF_W1P = 0, OFF_W1S = 32 * MiB, OFF_FB = 0, OFF_O = 48 * MiB, OFF_XB = 96 * MiB, OFF_Q = 96 * MiB, OFF_K = 168 * MiB,
                 OFF_VT = 240 * MiB, OFF_A2P = 288 * MiB, OFF_A2S = 320 * MiB, OFF_MH = 96 * MiB, OFF_ACT = 192 * MiB, OFF_CQ = 384 * MiB,
                 OFF_CKV = 420 * MiB, OFF_KPE = 444 * MiB, OFF_WT = 456 * MiB;
constexpr size_t OFF_WIN = OFF_WT;
constexpr size_t OFF_WF = OFF_WIN + (size_t)3840 * 1024 * 2;
constexpr size_t OFF_WAT = OFF_WF + (size_t)1024 * 512 * 2;
constexpr size_t OFF_WO = OFF_WAT + (size_t)1024 * 512 * 2;
constexpr size_t OFF_WGU = OFF_WO + (size_t)1024 * 1024 * 2;
constexpr size_t OFF_WD = OFF_WGU + (size_t)5632 * 1024 * 2;
constexpr size_t OFF_WUQ = OFF_WD + (size_t)1024 * 2816 * 2;
constexpr size_t OFF_WUKV = OFF_WUQ + (size_t)768 * 384 * 2;
constexpr size_t OFF_FA128 = OFF_WUKV + (size_t)1024 * 256 * 2;
constexpr size_t OFF_FA64 = OFF_FA128 + (size_t)256 * 256 * 2;
constexpr size_t OFF_FB128 = OFF_FA64 + (size_t)128 * 128 * 2;
constexpr size_t OFF_FB64 = OFF_FB128 + (size_t)128 * 256 * 2;
constexpr size_t OFF_ROPE = OFF_FB64 + (size_t)128 * 128 * 2;
constexpr size_t OFF_STATS = OFF_ROPE + (size_t)16384 * 16 * 8;
constexpr size_t WS_END = OFF_STATS + ((size_t)42 * T) * 4;

constexpr int GSTR = 144;
constexpr int KSTR = 208, VSTR = 136;
constexpr int LDS_BYTES = 131072;
constexpr float ALPHA = 1.189207115002721f;
constexpr float QSCALE = 0.10206207261596575f * 1.4426950408889634f;
constexpr int NPHASE = 10;

struct Params {
    const float *x_prompt, *x_sample, *w_in, *w_fourier, *g_q, *w_uq, *g_kv, *w_ukv, *w_attn, *w_o, *ln1_g, *ln1_b, *w_gate, *w_up, *w_down, *ln2_g, *ln2_b;
    float* out; unsigned char* ws; int ph_lo, ph_hi;
};

__device__ const double INVFREQ_D[16] = {1.0, 0.5623413251903491, 0.31622776601683794, 0.1778279410038923, 0.1, 0.05623413251903491, 0.03162277660168379, 0.01778279410038923,
                                         0.01, 0.005623413251903491, 0.0031622776601683794, 0.001778279410038923, 0.001, 0.0005623413251903491, 0.00031622776601683794, 0.0001778279410038923};

typedef __bf16 bf16x2_t __attribute__((ext_vector_type(2)));
__device__ __forceinline__ unsigned pk(float lo, float hi) { f32x2 v; v.x = lo; v.y = hi; const bf16x2_t b = __builtin_convertvector(v, bf16x2_t); return __builtin_bit_cast(unsigned, b); }
__device__ __forceinline__ void store_row32(bf16_t* base, const unsigned (&pv)[8], int h) {
#pragma unroll
    for (int k = 0; k < 4; k += 2) {
        unsigned ax = pv[2 * k], ay = pv[2 * k + 1], bx = pv[2 * k + 2], by = pv[2 * k + 3];
        { auto r_ = __builtin_amdgcn_permlane32_swap(ax, bx, false, false); ax = r_[0]; bx = r_[1]; }
        { auto r_ = __builtin_amdgcn_permlane32_swap(ay, by, false, false); ay = r_[0]; by = r_[1]; }
        u32x4 w; w.x = ax; w.y = ay; w.z = bx; w.w = by;
        *(u32x4*)(base + 8 * k + 8 * h) = w;
    }
}
__device__ __forceinline__ void load_row32(const bf16_t* base, unsigned (&pv)[8], int h) {
#pragma unroll
    for (int k = 0; k < 4; k += 2) {
        const u32x4 w = *(const u32x4*)(base + 8 * k + 8 * h);
        unsigned ax = w.x, ay = w.y, bx = w.z, by = w.w;
        { auto r_ = __builtin_amdgcn_permlane32_swap(ax, bx, false, false); ax = r_[0]; bx = r_[1]; }
        { auto r_ = __builtin_amdgcn_permlane32_swap(ay, by, false, false); ay = r_[0]; by = r_[1]; }
        pv[2 * k] = ax; pv[2 * k + 1] = ay; pv[2 * k + 2] = bx; pv[2 * k + 3] = by;
    }
}
__device__ __forceinline__ float cos_rev(float r) { return __builtin_amdgcn_cosf(r); }
__device__ __forceinline__ float sin_rev(float r) { return __builtin_amdgcn_sinf(r); }
__device__ __forceinline__ float bf2f(unsigned short v) { return __uint_as_float((unsigned)v << 16); }
__device__ __forceinline__ f32x16 mfma32(bf16x8 a, bf16x8 b, f32x16 c) { return __builtin_amdgcn_mfma_f32_32x32x16_bf16(a, b, c, 0, 0, 0); }
__device__ __forceinline__ void tok_info(int t, int& seq_start, int& S, int& pos) {
    if (t < TP) { seq_start = 0; S = 16384; pos = t; } else { const int u = t - TP; seq_start = TP + (u & ~4095); S = 4096; pos = u & 4095; }
}
__device__ __forceinline__ const float* xrow(const Params& p, int tok) { return tok < TP ? p.x_prompt + (size_t)tok * 1024 : p.x_sample + (size_t)(tok - TP) * 1024; }
__device__ __forceinline__ void zero_acc(f32x16 (&acc)[2][2]) {
#pragma unroll
    for (int a = 0; a < 2; ++a)
#pragma unroll
        for (int b = 0; b < 2; ++b)
#pragma unroll
            for (int e = 0; e < 16; ++e) acc[a][b][e] = 0.f;
}

template <bool SWAP>
__device__ __forceinline__ void gemm_core(const int tid, LAS unsigned char* lds, const bf16_t* __restrict__ Ab, const unsigned (&ao)[4], const bf16_t* __restrict__ Bb, const unsigned (&bo)[4], int K, f32x16 (&acc)[2][2]) {
    const int lane = tid & 63, wid = tid >> 6, wm = wid >> 1, wn = wid & 1;
    const int w = __builtin_amdgcn_readfirstlane(wid);
    const int c32 = lane & 31, t3 = (lane >> 5) ^ ((c32 >> 1) & 7);
    const int aoff = (wm * 64 + c32) * 128 + t3 * 16;
    const int boff = 16384 + (wn * 64 + c32) * 128 + t3 * 16;
    const int nk = K >> 6;
#define GEMM_ISSUE(kt_, buf_) do { _Pragma("unroll") for (int j_ = 0; j_ < 4; ++j_) { \
        __builtin_amdgcn_global_load_lds((const unsigned*)(Ab + (ao[j_] + (unsigned)(kt_) * 64u)), (LAS unsigned*)(lds + (buf_) * 32768 + (w + 4 * j_) * 1024), 16, 0, 0); \
        __builtin_amdgcn_global_load_lds((const unsigned*)(Bb + (bo[j_] + (unsigned)(kt_) * 64u)), (LAS unsigned*)(lds + (buf_) * 32768 + 16384 + (w + 4 * j_) * 1024), 16, 0, 0); } } while (0)
    GEMM_ISSUE(0, 0);
#pragma unroll 1
    for (int kt = 0; kt < nk; ++kt) {
        asm volatile("s_waitcnt vmcnt(0)" ::: "memory");
        __syncthreads();
        if (kt + 1 < nk) GEMM_ISSUE(kt + 1, (kt + 1) & 1);
        LAS unsigned char* sb = lds + (kt & 1) * 32768;
        bf16x8 fa[2][2], fb[2][2];
        fa[0][0] = *(const LAS bf16x8*)(sb + aoff); fa[0][1] = *(const LAS bf16x8*)(sb + aoff + 32 * 128);
        fb[0][0] = *(const LAS bf16x8*)(sb + boff); fb[0][1] = *(const LAS bf16x8*)(sb + boff + 32 * 128);
#pragma unroll
        for (int kk = 0; kk < 4; ++kk) {
            const int c = kk & 1, n = c ^ 1;
            if (kk < 3) {
                fa[n][0] = *(const LAS bf16x8*)(sb + (aoff ^ ((kk + 1) * 32))); fa[n][1] = *(const LAS bf16x8*)(sb + ((aoff + 32 * 128) ^ ((kk + 1) * 32)));
                fb[n][0] = *(const LAS bf16x8*)(sb + (boff ^ ((kk + 1) * 32))); fb[n][1] = *(const LAS bf16x8*)(sb + ((boff + 32 * 128) ^ ((kk + 1) * 32)));
            }
            if (SWAP) { acc[0][0] = mfma32(fb[c][0], fa[c][0], acc[0][0]); acc[0][1] = mfma32(fb[c][1], fa[c][0], acc[0][1]); acc[1][0] = mfma32(fb[c][0], fa[c][1], acc[1][0]); acc[1][1] = mfma32(fb[c][1], fa[c][1], acc[1][1]); }
            else      { acc[0][0] = mfma32(fa[c][0], fb[c][0], acc[0][0]); acc[0][1] = mfma32(fa[c][0], fb[c][1], acc[0][1]); acc[1][0] = mfma32(fa[c][1], fb[c][0], acc[1][0]); acc[1][1] = mfma32(fa[c][1], fb[c][1], acc[1][1]); }
        }
    }
#undef GEMM_ISSUE
    __syncthreads();
}

__device__ __forceinline__ bool xcd_tile(int it, int NT, int& mt, int& jt) {
    const int G = gridDim.x, b = blockIdx.x;
    if (G & 7) { const int tile = b + it * G; if (tile >= 384 * NT) return false; mt = tile / NT; jt = tile - mt * NT; return true; }
    const int xcd = b & 7, local = b >> 3, nloc = G >> 3;
    const int o = local + it * nloc; if (o >= 48 * NT) return false;
    const int pw = 8 * NT, pnl = o / pw, idx = o - pnl * pw;
    jt = idx >> 3; mt = 48 * xcd + 8 * pnl + (idx & 7); return true;
}

__device__ __forceinline__ void zero_acc4(f32x16 (&acc)[4][2]) {
#pragma unroll
    for (int a = 0; a < 4; ++a)
#pragma unroll
        for (int b = 0; b < 2; ++b)
#pragma unroll
            for (int e = 0; e < 16; ++e) acc[a][b][e] = 0.f;
}
template <bool SWAP>
__device__ __forceinline__ void gemm_core256(const int tid, LAS unsigned char* lds, const bf16_t* __restrict__ Ab, const unsigned (&ao)[4], const bf16_t* __restrict__ Bb, const unsigned (&bo)[4], int K, f32x16 (&acc)[4][2]) {
    const int lane = tid & 63, wid = tid >> 6, wm = wid >> 2, wn = wid & 3;
    const int w = __builtin_amdgcn_readfirstlane(wid);
    const int grp = w >> 2;
    const int c32 = lane & 31, t2 = (lane >> 5) ^ ((c32 >> 2) & 3);
    const int aoff = (wm * 128 + c32) * 64 + t2 * 16;
    const int boff = 16384 + (wn * 64 + c32) * 64 + t2 * 16;
    const int nk = K >> 5;
#define G256_ISSUE1(j_, kt_, buf_) do { \
        __builtin_amdgcn_global_load_lds((const unsigned*)(Ab + (ao[j_] + (unsigned)(kt_) * 32u)), (LAS unsigned*)(lds + (buf_) * 32768 + (w + 8 * (j_)) * 1024), 16, 0, 0); \
        __builtin_amdgcn_global_load_lds((const unsigned*)(Bb + (bo[j_] + (unsigned)(kt_) * 32u)), (LAS unsigned*)(lds + (buf_) * 32768 + 16384 + (w + 8 * (j_)) * 1024), 16, 0, 0); } while (0)
#define G256_BAR do { asm volatile("" ::: "memory"); __builtin_amdgcn_s_barrier(); asm volatile("" ::: "memory"); } while (0)
#define G256_SB __builtin_amdgcn_sched_barrier(0)
#define G256_LDA do { _Pragma("unroll") for (int i_ = 0; i_ < 4; ++i_) _Pragma("unroll") for (int k_ = 0; k_ < 2; ++k_) \
        fa[i_][k_] = *(const LAS bf16x8*)(sb + ((aoff + i_ * 32 * 64) ^ (k_ * 32))); } while (0)
#define G256_LDB do { _Pragma("unroll") for (int n_ = 0; n_ < 2; ++n_) _Pragma("unroll") for (int k_ = 0; k_ < 2; ++k_) \
        fb[n_][k_] = *(const LAS bf16x8*)(sb + ((boff + n_ * 32 * 64) ^ (k_ * 32))); } while (0)
#define G256_MMA do { _Pragma("unroll") for (int k_ = 0; k_ < 2; ++k_) _Pragma("unroll") for (int i_ = 0; i_ < 4; ++i_) _Pragma("unroll") for (int n_ = 0; n_ < 2; ++n_) { \
        if (SWAP) acc[i_][n_] = mfma32(fb[n_][k_], fa[i_][k_], acc[i_][n_]); else acc[i_][n_] = mfma32(fa[i_][k_], fb[n_][k_], acc[i_][n_]); } \
        } while (0)
#define G256_ENDL do { asm volatile("s_waitcnt lgkmcnt(0)" ::: "memory"); G256_SB; G256_BAR; G256_SB; } while (0)
    G256_ISSUE1(0, 0, 0); G256_ISSUE1(1, 0, 0);
    if (nk > 1) { G256_ISSUE1(0, 1, 1); G256_ISSUE1(1, 1, 1); asm volatile("s_waitcnt vmcnt(4)" ::: "memory"); }
    else asm volatile("s_waitcnt vmcnt(0)" ::: "memory");
    G256_BAR;
    if (grp == 1) G256_BAR;
#pragma unroll 1
    for (int kt = 0; kt < nk; ++kt) {
        LAS unsigned char* sb = lds + (kt & 3) * 32768; const int nb = (kt + 2) & 3; const bool more2 = kt + 2 < nk;
        bf16x8 fa[4][2], fb[2][2];
        G256_SB; G256_LDA; G256_LDB;
        if (more2) { G256_ISSUE1(0, kt + 2, nb); G256_ISSUE1(1, kt + 2, nb); asm volatile("s_waitcnt vmcnt(4)" ::: "memory"); } else asm volatile("s_waitcnt vmcnt(0)" ::: "memory");
        G256_ENDL;
        G256_MMA; G256_SB; G256_BAR; G256_SB;
    }
    if (grp == 0) G256_BAR;
#undef G256_ENDL
#undef G256_MMA
#undef G256_LDB
#undef G256_LDA
#undef G256_SB
#undef G256_BAR
#undef G256_ISSUE1
}

__device__ __forceinline__ bool xcd_tile256(int it, int NT, int& mt, int& jt) {
    const int G = gridDim.x, b = blockIdx.x;
    if (G & 7) { const int tile = b + it * G; if (tile >= 192 * NT) return false; mt = tile / NT; jt = tile - mt * NT; return true; }
    const int xcd = b & 7, local = b >> 3, nloc = G >> 3;
    const int o = local + it * nloc; if (o >= 24 * NT) return false;
    const int pw = 4 * NT, pnl = o / pw, idx = o - pnl * pw;
    jt = idx >> 2; mt = 24 * xcd + 4 * pnl + (idx & 3); return true;
}

template <class F>
__device__ __forceinline__ void transpose_job(const int tid, const int half, LAS unsigned char* lds, bf16_t* dst, int K, int N, F f) {
    LAS float* tl = (LAS float*)lds;
    const int ntn = N >> 6, ntk = K >> 6, nt = ntn * ntk;
    for (int t0 = blockIdx.x * 2; t0 < nt; t0 += gridDim.x * 2) {
        const int tile = (t0 + half < nt) ? t0 + half : nt - 1;
        const int n0 = (tile / ntk) << 6, k0 = (tile % ntk) << 6;
        __syncthreads();
#pragma unroll 4
        for (int r = 0; r < 16; ++r) { const int kl = (tid >> 6) + 4 * r, nl = tid & 63; tl[kl * 65 + nl] = f(k0 + kl, n0 + nl); }
        __syncthreads();
        const int nl = tid >> 2, kq = tid & 3;
        u32x4 w0, w1;
        w0.x = pk(tl[(kq * 16 + 0) * 65 + nl], tl[(kq * 16 + 1) * 65 + nl]); w0.y = pk(tl[(kq * 16 + 2) * 65 + nl], tl[(kq * 16 + 3) * 65 + nl]);
        w0.z = pk(tl[(kq * 16 + 4) * 65 + nl], tl[(kq * 16 + 5) * 65 + nl]); w0.w = pk(tl[(kq * 16 + 6) * 65 + nl], tl[(kq * 16 + 7) * 65 + nl]);
        w1.x = pk(tl[(kq * 16 + 8) * 65 + nl], tl[(kq * 16 + 9) * 65 + nl]); w1.y = pk(tl[(kq * 16 + 10) * 65 + nl], tl[(kq * 16 + 11) * 65 + nl]);
        w1.z = pk(tl[(kq * 16 + 12) * 65 + nl], tl[(kq * 16 + 13) * 65 + nl]); w1.w = pk(tl[(kq * 16 + 14) * 65 + nl], tl[(kq * 16 + 15) * 65 + nl]);
        bf16_t* d = dst + (size_t)(n0 + nl) * K + k0 + kq * 16;
        *(u32x4*)d = w0; *(u32x4*)(d + 8) = w1;
    }
    __syncthreads();
}

__device__ void phase_prep(const Params& p, LAS unsigned char* lds_) {
    int tid_ = threadIdx.x; asm volatile("" : "+v"(tid_)); const int half = tid_ >> 8, tid = tid_ & 255, bid = blockIdx.x * 2 + half, gsz = gridDim.x * 2;
    LAS unsigned char* lds = lds_ + half * 65536;
    const size_t gtid = (size_t)bid * 256 + tid, gth = (size_t)gsz * 256;
    unsigned char* ws = p.ws;
#ifdef EXP_CANARY
    { u32x4 v; v.x = v.y = v.z = v.w = 0x7fc07fc0u;
      u32x4* a = (u32x4*)(ws + OFF_CQ); for (size_t i = gtid; i < (size_t)63 * MiB / 16; i += gth) a[i] = v;
      u32x4* b = (u32x4*)(ws + OFF_STATS); for (size_t i = gtid; i < (size_t)42 * T * 4 / 16; i += gth) b[i] = v;
      u32x4* c = (u32x4*)p.out; for (size_t i = gtid; i < (size_t)192 * MiB / 16; i += gth) c[i] = v; }
#endif
    { bf16_t* xb = (bf16_t*)(ws + OFF_XB);
      for (size_t i = gtid; i < (size_t)T * 1024 / 8; i += gth) {
          const size_t e = i * 8; const float* src = (e < (size_t)TP * 1024) ? p.x_prompt + e : p.x_sample + (e - (size_t)TP * 1024);
          const f32x4 a = *(const f32x4*)src, b = *(const f32x4*)(src + 4);
          u32x4 w; w.x = pk(a[0], a[1]); w.y = pk(a[2], a[3]); w.z = pk(b[0], b[1]); w.w = pk(b[2], b[3]);
          *(u32x4*)(xb + e) = w; } }
    { f32x2* rope = (f32x2*)(ws + OFF_ROPE);
      for (size_t i = gtid; i < (size_t)16384 * 16; i += gth) {
          const int s = (int)(i >> 4), j = (int)(i & 15); const float invf = (float)INVFREQ_D[j]; const float ang = (float)s * invf;
          double rev = (double)ang * 0.15915494309189535; rev -= floor(rev); const float r = (float)rev;
          f32x2 v; v.x = cos_rev(r); v.y = sin_rev(r); rope[i] = v; } }
    { bf16_t* fa = (bf16_t*)(ws + OFF_FA128);
      for (size_t i = gtid; i < (size_t)256 * 256; i += gth) { const int n = (int)(i >> 8), k = (int)(i & 255); const int ro = (n >> 5) & 1, k1 = (n >> 6) * 32 + (n & 31), n1 = k >> 1, ri = k & 1;
          const float r = (float)((k1 * n1) & 127) * (1.f / 128.f); const float c = cos_rev(r), s = sin_rev(r); const float v = ro == 0 ? (ri == 0 ? c : s) : (ri == 0 ? -s : c);
          fa[i] = (bf16_t)(pk(v, 0.f) & 0xffff); }
      bf16_t* fa6 = (bf16_t*)(ws + OFF_FA64);
      for (size_t i = gtid; i < (size_t)128 * 128; i += gth) { const int n = (int)(i >> 7), k = (int)(i & 127); const int ro = (n >> 5) & 1, k1 = (n >> 6) * 32 + (n & 31), n1 = k >> 1, ri = k & 1;
          const float r = (float)((k1 * n1) & 63) * (1.f / 64.f); const float c = cos_rev(r), s = sin_rev(r); const float v = ro == 0 ? (ri == 0 ? c : s) : (ri == 0 ? -s : c);
          fa6[i] = (bf16_t)(pk(v, 0.f) & 0xffff); }
      bf16_t* fb = (bf16_t*)(ws + OFF_FB128);
      for (size_t i = gtid; i < (size_t)128 * 256; i += gth) { const int k2 = (int)(i >> 8), k = (int)(i & 255); const int n2 = k >> 1, ri = k & 1;
          const float r = (float)((k2 * n2) & 127) * (1.f / 128.f); const float v = ri == 0 ? cos_rev(r) : sin_rev(r); fb[i] = (bf16_t)(pk(v, 0.f) & 0xffff); }
      bf16_t* fb6 = (bf16_t*)(ws + OFF_FB64);
      for (size_t i = gtid; i < (size_t)128 * 128; i += gth) { const int k2 = (int)(i >> 7), k = (int)(i & 127); const int n2 = k >> 1, ri = k & 1;
          const float r = (float)((k2 * n2) & 63) * (1.f / 64.f); float v = ri == 0 ? cos_rev(r) : sin_rev(r); if (k2 >= 64) v = 0.f; fb6[i] = (bf16_t)(pk(v, 0.f) & 0xffff); } }
    { LAS float* cs = (LAS float*)lds; LAS float* sn = cs + 128;
      __syncthreads();
      if (tid < 128) { const float r = (float)tid * (1.f / 128.f); cs[tid] = cos_rev(r); sn[tid] = sin_rev(r); }
      __syncthreads();
      bf16_t* wt = (bf16_t*)(ws + OFF_WIN);
      for (int it = bid; it < 1024 * 4; it += gsz) {
          const int k = it >> 2, n = (it & 3) * 256 + tid;
          const int jt = n >> 7, cl = n & 127, g = jt >> 1, hf = jt & 1, sub = cl >> 5, cc = cl & 31, wn = sub >> 1, reim = sub & 1, cp = hf * 64 + wn * 32 + cc;
          const float* wr = p.w_in + (size_t)k * 3232 + g * 128;
          float acc = 0.f;
          for (int c = 0; c < 128; c += 4) {
              const f32x4 w4 = *(const f32x4*)(wr + c);
#pragma unroll
              for (int e = 0; e < 4; ++e) { const int idx = ((c + e) * cp) & 127; const float tw = reim ? -sn[idx] : cs[idx]; acc += w4[e] * tw; }
          }
          wt[(size_t)n * 1024 + k] = (bf16_t)(pk(acc, 0.f) & 0xffff);
      }
      __syncthreads(); }
    { const float* w_in = p.w_in;
      transpose_job(tid, half, lds, (bf16_t*)(ws + OFF_WIN) + (size_t)1024 * 1024, 1024, 2816, [=](int k, int n) -> float {
          int src; if (n < 384) src = 512 + n; else if (n < 640) src = 896 + (n - 384); else if (n < 768) src = (n - 640 < 32) ? 1152 + (n - 640) : -1; else src = 1184 + (n - 768);
          return src >= 0 ? w_in[(size_t)k * 3232 + src] : 0.f; }); }
    { const float* w = p.w_fourier; transpose_job(tid, half, lds, (bf16_t*)(ws + OFF_WF), 512, 1024, [=](int k, int n) -> float { return w[(size_t)k * 1024 + n]; }); }
    { const float* w = p.w_attn; transpose_job(tid, half, lds, (bf16_t*)(ws + OFF_WAT), 512, 1024, [=](int k, int n) -> float { return w[(size_t)k * 1024 + n]; }); }
    { const float* w = p.w_o; transpose_job(tid, half, lds, (bf16_t*)(ws + OFF_WO), 1024, 1024, [=](int k, int n) -> float { return w[(size_t)k * 1024 + n]; }); }
    { const float* wg = p.w_gate; const float* wu = p.w_up;
      transpose_job(tid, half, lds, (bf16_t*)(ws + OFF_WGU), 1024, 5632, [=](int k, int n) -> float { const int grp = n >> 6, r = n & 63; return r < 32 ? wg[(size_t)k * 2816 + grp * 32 + r] : wu[(size_t)k * 2816 + grp * 32 + r - 32]; }); }
    { const float* w = p.w_down; transpose_job(tid, half, lds, (bf16_t*)(ws + OFF_WD), 2816, 1024, [=](int k, int n) -> float { return w[(size_t)k * 1024 + n]; }); }
    { const float* w = p.w_uq; const float* g = p.g_q; transpose_job(tid, half, lds, (bf16_t*)(ws + OFF_WUQ), 384, 768, [=](int k, int n) -> float { return w[(size_t)k * 768 + n] * g[k]; }); }
    { const float* w = p.w_ukv; const float* g = p.g_kv;
      transpose_job(tid, half, lds, (bf16_t*)(ws + OFF_WUKV), 256, 1024, [=](int k, int n) -> float { const int col = n < 512 ? (n >> 6) * 128 + (n & 63) : ((n - 512) >> 6) * 128 + 64 + (n & 63); return w[(size_t)k * 1024 + col] * g[k]; }); }
}

__device__ __forceinline__ int p1_token(int mt, int i) {
    if (mt < 128) return 128 * i + mt;
    const int idx = mt - 128, b = idx >> 5, pr = idx & 31;
    return TP + b * 4096 + 64 * (i & 63) + 2 * pr + (i >> 6);
}

__device__ void phase_inproj(const Params& p, LAS unsigned char* lds) {
    int tid_ = threadIdx.x; asm volatile("" : "+v"(tid_)); const int tid = tid_, lane = tid & 63, wid = tid >> 6, wm2 = wid >> 2, wn4 = wid & 3, c32 = lane & 31, h = lane >> 5;
    const int lrow = tid >> 2, lkc = (tid & 3) ^ ((tid >> 4) & 3);
    unsigned char* ws = p.ws;
    const bf16_t* xb = (const bf16_t*)(ws + OFF_XB); const bf16_t* wt = (const bf16_t*)(ws + OFF_WIN);
    float* stats = (float*)(ws + OFF_STATS);
    int mt2, jt2;
    for (int it = 0; xcd_tile256(it, 15, mt2, jt2); ++it) {
        unsigned ao[4], bo[4];
#pragma unroll
        for (int j = 0; j < 4; ++j) { const int r = lrow + 128 * (j & 1); ao[j] = (unsigned)((size_t)p1_token(2 * mt2 + (r >> 7), r & 127) * 1024 + lkc * 8); bo[j] = (unsigned)((size_t)(jt2 * 256 + r) * 1024 + lkc * 8); }
        f32x16 acc4[4][2]; zero_acc4(acc4);
        if (jt2 < 4) gemm_core256<false>(tid, lds, xb, ao, wt, bo, 1024, acc4); else gemm_core256<true>(tid, lds, xb, ao, wt, bo, 1024, acc4);
        int le_ = lane; asm volatile("" : "+v"(le_));
#pragma unroll
        for (int mh = 0; mh < 2; ++mh) {
            const int c32 = le_ & 31, h = le_ >> 5;
            const int mt = 2 * mt2 + wm2, jt = 2 * jt2 + (wn4 >> 1), wm = mh, wn = wn4 & 1;
            f32x16 (&acc)[2][2] = reinterpret_cast<f32x16 (&)[2][2]>(acc4[2 * mh]);
        if (jt < 8) {
            const int cp = (jt & 1) * 64 + wn * 32 + c32, ch = (jt >> 1) * 128 + cp;
#pragma unroll
            for (int mi = 0; mi < 2; ++mi)
#pragma unroll
                for (int q = 0; q < 4; ++q) {
                    const int i0 = wm * 64 + mi * 32 + 8 * q + 4 * h;
                    bf16_t* dst;
                    if (mt < 128) dst = (bf16_t*)(ws + OFF_W1P) + (((size_t)ch * 128 + mt) * 128 + i0) * 2;
                    else { const int idx = mt - 128, b = idx >> 5, pr = idx & 31; dst = (bf16_t*)(ws + OFF_W1S) + ((((size_t)b * 512 + ch) * 64 + 2 * pr + (i0 >> 6)) * 64 + (i0 & 63)) * 2; }
                    u32x4 w; w.x = pk(acc[mi][0][4 * q], acc[mi][1][4 * q]); w.y = pk(acc[mi][0][4 * q + 1], acc[mi][1][4 * q + 1]);
                    w.z = pk(acc[mi][0][4 * q + 2], acc[mi][1][4 * q + 2]); w.w = pk(acc[mi][0][4 * q + 3], acc[mi][1][4 * q + 3]);
                    *(u32x4*)dst = w;
                }
        } else {
#pragma unroll
            for (int mi = 0; mi < 2; ++mi) {
                const int tok = p1_token(mt, wm * 64 + mi * 32 + c32);
                if (jt < 13) {
                    const bool isq = jt < 11; bf16_t* dstrow = isq ? (bf16_t*)(ws + OFF_CQ) + (size_t)tok * 384 + (jt - 8) * 128 : (bf16_t*)(ws + OFF_CKV) + (size_t)tok * 256 + (jt - 11) * 128;
                    float ss = 0.f;
#pragma unroll
                    for (int ni = 0; ni < 2; ++ni) {
                        unsigned pv[8];
#pragma unroll
                        for (int q = 0; q < 4; ++q) {
                            const float v0 = acc[mi][ni][4 * q], v1 = acc[mi][ni][4 * q + 1], v2 = acc[mi][ni][4 * q + 2], v3 = acc[mi][ni][4 * q + 3];
                            ss += v0 * v0 + v1 * v1 + v2 * v2 + v3 * v3;
                            pv[2 * q] = pk(v0, v1); pv[2 * q + 1] = pk(v2, v3);
                        }
                        store_row32(dstrow + wn * 64 + ni * 32, pv, h);
                    }
                    ss += __shfl_xor(ss, 32);
                    if (h == 0) { if (isq) stats[(size_t)tok * 6 + (jt - 8) * 2 + wn] = ss; else stats[(size_t)6 * T + (size_t)tok * 4 + (jt - 11) * 2 + wn] = ss; }
                } else if (jt == 13) {
                    if (wn == 0) {
                        int ss_, S_, pos; tok_info(tok, ss_, S_, pos);
                        const f32x2* rope = (const f32x2*)(ws + OFF_ROPE) + (size_t)pos * 16;
                        bf16_t* dstrow = (bf16_t*)(ws + OFF_KPE) + (size_t)tok * 32;
#pragma unroll
                        for (int q = 0; q < 2; ++q) {
                            const int j0 = 8 * q + 4 * h;
                            float o1[4], o2[4];
#pragma unroll
                            for (int e = 0; e < 4; ++e) { const f32x2 cs = rope[j0 + e]; const float x1 = acc[mi][0][4 * q + e], x2 = acc[mi][0][4 * (q + 2) + e]; o1[e] = x1 * cs.x - x2 * cs.y; o2[e] = x2 * cs.x + x1 * cs.y; }
                            u32x2 w; w.x = pk(o1[0], o1[1]); w.y = pk(o1[2], o1[3]); *(u32x2*)(dstrow + j0) = w;
                            w.x = pk(o2[0], o2[1]); w.y = pk(o2[2], o2[3]); *(u32x2*)(dstrow + 16 + j0) = w;
                        }
                    }
                } else {
                    bf16_t* dstrow = (bf16_t*)p.out + (size_t)tok * 2048 + (jt - 14) * 128;
#pragma unroll
                    for (int ni = 0; ni < 2; ++ni) {
                        unsigned pv[8];
#pragma unroll
                        for (int q = 0; q < 4; ++q) {
                            float v[4];
#pragma unroll
                            for (int e = 0; e < 4; ++e) v[e] = __builtin_amdgcn_rcpf(1.f + __expf(-acc[mi][ni][4 * q + e]));
                            pv[2 * q] = pk(v[0], v[1]); pv[2 * q + 1] = pk(v[2], v[3]);
                        }
                        store_row32(dstrow + wn * 64 + ni * 32, pv, h);
                    }
                }
            }
        }
        }
    }
}

__device__ void phase_up(const Params& p, LAS unsigned char* lds_) {
    unsigned char* ws = p.ws;
    const float* stats = (const float*)(ws + OFF_STATS);
    {
        int t8_ = threadIdx.x; asm volatile("" : "+v"(t8_)); const int tid8 = t8_, lane8 = tid8 & 63, wid8 = tid8 >> 6, wm2 = wid8 >> 2, wn4 = wid8 & 3;
        const int lrow8 = tid8 >> 2, lkc8 = (tid8 & 3) ^ ((tid8 >> 4) & 3);
        for (int tile = blockIdx.x; tile < 576 + 768; tile += gridDim.x) {
            unsigned ao[4], bo[4];
            f32x16 acc4[4][2]; zero_acc4(acc4);
            if (tile < 576) {
                const int mt2 = tile / 3, jt2 = tile - mt2 * 3;
                const bf16_t* A = (const bf16_t*)(ws + OFF_CQ); const bf16_t* B = (const bf16_t*)(ws + OFF_WUQ);
#pragma unroll
                for (int j = 0; j < 4; ++j) { const int r = lrow8 + 128 * (j & 1); ao[j] = (unsigned)((size_t)(mt2 * 256 + r) * 384 + lkc8 * 8); bo[j] = (unsigned)((size_t)(jt2 * 256 + r) * 384 + lkc8 * 8); }
                gemm_core256<true>(tid8, lds_, A, ao, B, bo, 384, acc4);
        int le_ = lane8; asm volatile("" : "+v"(le_));
#pragma unroll
        for (int mh = 0; mh < 2; ++mh) {
            const int c32 = le_ & 31, h = le_ >> 5;
            const int mt = 2 * mt2 + wm2, jt = 2 * jt2 + (wn4 >> 1), wm = mh, wn = wn4 & 1;
            f32x16 (&acc)[2][2] = reinterpret_cast<f32x16 (&)[2][2]>(acc4[2 * mh]);
#pragma unroll
            for (int mi = 0; mi < 2; ++mi) {
                const int tok = mt * 128 + wm * 64 + mi * 32 + c32; int ss_, S_, pos; tok_info(tok, ss_, S_, pos);
                const f32x2 pa = *(const f32x2*)(stats + (size_t)tok * 6), pb = *(const f32x2*)(stats + (size_t)tok * 6 + 2), pc = *(const f32x2*)(stats + (size_t)tok * 6 + 4);
                const float rs = rsqrtf((((pa.x + pa.y) + (pb.x + pb.y)) + (pc.x + pc.y)) * (1.f / 384.f) + 1e-6f) * QSCALE;
#pragma unroll
                for (int ni = 0; ni < 2; ++ni) {
                    const int nt = jt * 4 + wn * 2 + ni, head = nt / 3, part = nt - 3 * head;
                    bf16_t* qd = (bf16_t*)(ws + OFF_Q) + ((size_t)ss_ * 8 + (size_t)head * S_ + pos) * 96;
                    if (part < 2) {
                        unsigned pv[8];
#pragma unroll
                        for (int q = 0; q < 4; ++q) { pv[2 * q] = pk(acc[mi][ni][4 * q] * rs, acc[mi][ni][4 * q + 1] * rs); pv[2 * q + 1] = pk(acc[mi][ni][4 * q + 2] * rs, acc[mi][ni][4 * q + 3] * rs); }
                        store_row32(qd + part * 32, pv, h);
                    } else {
                        const f32x2* rope = (const f32x2*)(ws + OFF_ROPE) + (size_t)pos * 16;
#pragma unroll
                        for (int q = 0; q < 2; ++q) {
                            const int j0 = 8 * q + 4 * h; float o1[4], o2[4];
#pragma unroll
                            for (int e = 0; e < 4; ++e) { const f32x2 cs = rope[j0 + e]; const float x1 = acc[mi][ni][4 * q + e] * rs, x2 = acc[mi][ni][4 * (q + 2) + e] * rs; o1[e] = x1 * cs.x - x2 * cs.y; o2[e] = x2 * cs.x + x1 * cs.y; }
                            u32x2 w; w.x = pk(o1[0], o1[1]); w.y = pk(o1[2], o1[3]); *(u32x2*)(qd + 64 + j0) = w;
                            w.x = pk(o2[0], o2[1]); w.y = pk(o2[2], o2[3]); *(u32x2*)(qd + 80 + j0) = w;
                        }
                    }
                }
            }
        }
            } else {
                const int t2 = tile - 576, mt2 = t2 >> 2, jt2 = t2 & 3;
                const bf16_t* A = (const bf16_t*)(ws + OFF_CKV); const bf16_t* B = (const bf16_t*)(ws + OFF_WUKV);
#pragma unroll
                for (int j = 0; j < 4; ++j) { const int r = lrow8 + 128 * (j & 1); ao[j] = (unsigned)((size_t)(mt2 * 256 + r) * 256 + lkc8 * 8); bo[j] = (unsigned)((size_t)(jt2 * 256 + r) * 256 + lkc8 * 8); }
                if (jt2 < 2) {
                    gemm_core256<true>(tid8, lds_, A, ao, B, bo, 256, acc4);
        int le_ = lane8; asm volatile("" : "+v"(le_));
#pragma unroll
        for (int mh = 0; mh < 2; ++mh) {
            const int c32 = le_ & 31, h = le_ >> 5;
            const int mt = 2 * mt2 + wm2, jt = 2 * jt2 + (wn4 >> 1), wm = mh, wn = wn4 & 1;
            f32x16 (&acc)[2][2] = reinterpret_cast<f32x16 (&)[2][2]>(acc4[2 * mh]);
                const int head = 2 * jt + wn;
#pragma unroll
                for (int mi = 0; mi < 2; ++mi) {
                    const int tok = mt * 128 + wm * 64 + mi * 32 + c32; int ss_, S_, pos; tok_info(tok, ss_, S_, pos);
                    const f32x4 pv = *(const f32x4*)(stats + (size_t)6 * T + (size_t)tok * 4);
                    const float rs = rsqrtf(((pv[0] + pv[1]) + (pv[2] + pv[3])) * (1.f / 256.f) + 1e-6f);
                    bf16_t* kd = (bf16_t*)(ws + OFF_K) + ((size_t)ss_ * 8 + (size_t)head * S_ + pos) * 96;
#pragma unroll
                    for (int ni = 0; ni < 2; ++ni) {
                        unsigned pv[8];
#pragma unroll
                        for (int q = 0; q < 4; ++q) { pv[2 * q] = pk(acc[mi][ni][4 * q] * rs, acc[mi][ni][4 * q + 1] * rs); pv[2 * q + 1] = pk(acc[mi][ni][4 * q + 2] * rs, acc[mi][ni][4 * q + 3] * rs); }
                        store_row32(kd + ni * 32, pv, h);
                    }
                }
        }
                } else {
                    gemm_core256<false>(tid8, lds_, A, ao, B, bo, 256, acc4);
        int le_ = lane8; asm volatile("" : "+v"(le_));
#pragma unroll
        for (int mh = 0; mh < 2; ++mh) {
            const int c32 = le_ & 31, h = le_ >> 5;
            const int mt = 2 * mt2 + wm2, jt = 2 * jt2 + (wn4 >> 1), wm = mh, wn = wn4 & 1;
            f32x16 (&acc)[2][2] = reinterpret_cast<f32x16 (&)[2][2]>(acc4[2 * mh]);
                const int head = 2 * (jt - 4) + wn;
#pragma unroll
                for (int mi = 0; mi < 2; ++mi)
#pragma unroll
                    for (int q = 0; q < 4; ++q) {
                        const int tok0 = mt * 128 + wm * 64 + mi * 32 + 8 * q + 4 * h; int ss_, S_, pos; tok_info(tok0, ss_, S_, pos);
                        const float* sp = stats + (size_t)6 * T + (size_t)tok0 * 4;
                        const f32x4 q0 = *(const f32x4*)sp, q1 = *(const f32x4*)(sp + 4), q2 = *(const f32x4*)(sp + 8), q3 = *(const f32x4*)(sp + 12);
                        const float r0 = rsqrtf(((q0[0] + q0[1]) + (q0[2] + q0[3])) * (1.f / 256.f) + 1e-6f), r1 = rsqrtf(((q1[0] + q1[1]) + (q1[2] + q1[3])) * (1.f / 256.f) + 1e-6f), r2 = rsqrtf(((q2[0] + q2[1]) + (q2[2] + q2[3])) * (1.f / 256.f) + 1e-6f), r3 = rsqrtf(((q3[0] + q3[1]) + (q3[2] + q3[3])) * (1.f / 256.f) + 1e-6f);
#pragma unroll
                        for (int ni = 0; ni < 2; ++ni) {
                            const int d = ni * 32 + c32;
                            bf16_t* vd = (bf16_t*)(ws + OFF_VT) + ((size_t)ss_ * 8 + (size_t)head * S_) * 64 + (size_t)d * S_ + pos;
                            u32x2 w; w.x = pk(acc[mi][ni][4 * q] * r0, acc[mi][ni][4 * q + 1] * r1); w.y = pk(acc[mi][ni][4 * q + 2] * r2, acc[mi][ni][4 * q + 3] * r3);
                            *(u32x2*)vd = w;
                        }
                    }
        }
                }
            }
        }
    }
    int tid_ = threadIdx.x; asm volatile("" : "+v"(tid_)); const int half = tid_ >> 8, tid = tid_ & 255, lane = tid & 63, wid = tid >> 6, wm = wid >> 1, wn = wid & 1, c32 = lane & 31, h = lane >> 5;
    const int lrow = tid >> 3, lkc = (tid & 7) ^ ((tid >> 4) & 7);
    LAS unsigned char* lds = lds_ + half * 65536;
    const int NQ = 0, NKV = 0, NFP = 1024, NFS = 2048, NTOT = NFP + NFS;
    for (int t0 = blockIdx.x * 2; t0 < NTOT; t0 += gridDim.x * 2) {
        const int tile = t0 + half;
        unsigned ao[4], bo[4];
        f32x16 acc[2][2]; zero_acc(acc);
        {
            const int t3 = tile - NQ - NKV; const bool prm = t3 < NFP;
            int K, jn, rowtile; const bf16_t* A; const bf16_t* B;
            if (prm) { rowtile = t3 >> 1; jn = t3 & 1; K = 256; A = (const bf16_t*)(ws + OFF_W1P); B = (const bf16_t*)(ws + OFF_FA128); }
            else { rowtile = t3 - NFP; jn = 0; K = 128; A = (const bf16_t*)(ws + OFF_W1S); B = (const bf16_t*)(ws + OFF_FA64); }
#pragma unroll
            for (int j = 0; j < 4; ++j) { const int i = lrow + 32 * j; ao[j] = (unsigned)(((size_t)rowtile * 128 + i) * K + lkc * 8); bo[j] = (unsigned)((size_t)(jn * 128 + i) * K + lkc * 8); }
            gemm_core<false>(tid, lds, A, ao, B, bo, K, acc);
            const int k1 = (jn * 2 + wn) * 32 + c32;
#pragma unroll
            for (int mi = 0; mi < 2; ++mi)
#pragma unroll
                for (int q = 0; q < 4; ++q) {
                    const int i0 = wm * 64 + mi * 32 + 8 * q + 4 * h;
                    int n2b; bf16_t* dst; float invS;
                    if (prm) { n2b = i0; dst = (bf16_t*)(ws + OFF_A2P) + (((size_t)k1 * 512 + rowtile) * 128 + n2b) * 2; invS = 1.f / 16384.f; }
                    else { const int b = rowtile >> 8, ch = 2 * (rowtile & 255) + (i0 >> 6); n2b = i0 & 63; dst = (bf16_t*)(ws + OFF_A2S) + ((((size_t)b * 64 + k1) * 512 + ch) * 64 + n2b) * 2; invS = 1.f / 4096.f; }
                    u32x4 w; unsigned wv[4];
#pragma unroll
                    for (int e = 0; e < 4; ++e) {
                        const float rev = (float)(k1 * (n2b + e)) * invS; const float c = cos_rev(rev), s = sin_rev(rev);
                        const float re = acc[mi][0][4 * q + e], im = acc[mi][1][4 * q + e];
                        wv[e] = pk(re * c + im * s, im * c - re * s);
                    }
                    w.x = wv[0]; w.y = wv[1]; w.z = wv[2]; w.w = wv[3];
                    *(u32x4*)dst = w;
                }
        }
    }
    { const size_t gtid = ((size_t)blockIdx.x * 2 + half) * 256 + tid, gth = (size_t)gridDim.x * 512;
      const bf16_t* kpe = (const bf16_t*)(ws + OFF_KPE); bf16_t* Kb = (bf16_t*)(ws + OFF_K);
      for (size_t i = gtid; i < (size_t)T * 32; i += gth) {
          const int c = (int)(i & 3), hh = (int)((i >> 2) & 7), tok = (int)(i >> 5); int ss_, S_, pos; tok_info(tok, ss_, S_, pos);
          const u32x4 v = *(const u32x4*)(kpe + (size_t)tok * 32 + c * 8);
          *(u32x4*)(Kb + ((size_t)ss_ * 8 + (size_t)hh * S_ + pos) * 96 + 64 + c * 8) = v; } }
}

__device__ __forceinline__ void attn_item(const int tid, LAS unsigned char* lds, const bf16_t* __restrict__ Qb, const bf16_t* __restrict__ Kb, const bf16_t* __restrict__ Vb, bf16_t* __restrict__ Ob, int S, int q0) {
    const int lane = tid & 63, w = tid >> 6, c32 = lane & 31, h = lane >> 5;
    bf16x8 qf[2][6];
#pragma unroll
    for (int u = 0; u < 2; ++u) { const bf16_t* qp = Qb + (size_t)(q0 + 64 * w + 32 * u + c32) * 96 + h * 8;
#pragma unroll
      for (int kk = 0; kk < 6; ++kk) qf[u][kk] = *(const bf16x8*)(qp + kk * 16); }
    f32x16 o[2][2];
#pragma unroll
    for (int u = 0; u < 2; ++u)
#pragma unroll
        for (int d = 0; d < 2; ++d)
#pragma unroll
            for (int e = 0; e < 16; ++e) o[u][d][e] = 0.f;
    float m_run[2] = {0.f, 0.f}, l_run[2] = {0.f, 0.f};
    LAS unsigned char* sK = lds; LAS unsigned char* sV = lds + 2 * 64 * KSTR;
    const int nkt = S >> 6;
    u32x4 rk[2], rv;
    rk[1].x = rk[1].y = rk[1].z = rk[1].w = 0u;
#define ATT_KOFS(c_) (((c_) / 12) * KSTR + ((c_) % 12) * 16)
#define ATT_VOFS(c_) (((c_) >> 3) * VSTR + ((c_) & 7) * 16)
#define ATT_VSRC(c_) ((unsigned)((c_) >> 3) * (unsigned)S + (unsigned)(((c_) & 7) * 8))
    rk[0] = *(const u32x4*)(Kb + (size_t)tid * 8);
    if (tid < 256) rk[1] = *(const u32x4*)(Kb + (size_t)(tid + 512) * 8);
    rv = *(const u32x4*)(Vb + ATT_VSRC(tid));
    __syncthreads();
    *(LAS u32x4*)(sK + ATT_KOFS(tid)) = rk[0];
    if (tid < 256) *(LAS u32x4*)(sK + ATT_KOFS(tid + 512)) = rk[1];
    *(LAS u32x2*)(sV + ATT_VOFS(tid)) = (u32x2){rv.x, rv.y}; *(LAS u32x2*)(sV + ATT_VOFS(tid) + 8) = (u32x2){rv.z, rv.w};
    __syncthreads();
#pragma unroll 1
    for (int kt = 0; kt < nkt; ++kt) {
        const int cur = kt & 1;
        LAS unsigned char* cK = sK + cur * 64 * KSTR; LAS unsigned char* cV = sV + cur * 64 * VSTR;
        int tl_ = tid; asm volatile("" : "+v"(tl_));
#pragma unroll
        for (int t = 0; t < 2; ++t) {
            f32x16 x[2];
#pragma unroll
            for (int u = 0; u < 2; ++u)
#pragma unroll
                for (int e = 0; e < 16; ++e) x[u][e] = -m_run[u];
#pragma unroll
            for (int kk = 0; kk < 6; ++kk) {
                const bf16x8 kf = *(const LAS bf16x8*)(cK + (32 * t + c32) * KSTR + kk * 32 + h * 16);
                x[0] = mfma32(kf, qf[0][kk], x[0]); x[1] = mfma32(kf, qf[1][kk], x[1]);
            }
            if (t == 0) {
                __builtin_amdgcn_sched_barrier(0);
                if (kt + 1 < nkt) {
                    rk[0] = *(const u32x4*)(Kb + (size_t)(kt + 1) * 64 * 96 + (size_t)tl_ * 8);
                    if (tl_ < 256) rk[1] = *(const u32x4*)(Kb + (size_t)(kt + 1) * 64 * 96 + (size_t)(tl_ + 512) * 8);
                    rv = *(const u32x4*)(Vb + ATT_VSRC(tl_) + (size_t)(kt + 1) * 64);
                }
            }
            union PF { u32x4 u; bf16x8 b; } pf[2][2];
#pragma unroll
            for (int u = 0; u < 2; ++u) {
                float mx = fmaxf(fmaxf(x[u][0], x[u][1]), x[u][2]);
#pragma unroll
                for (int e = 3; e < 15; e += 2) mx = fmaxf(fmaxf(mx, x[u][e]), x[u][e + 1]);
                mx = fmaxf(mx, x[u][15]);
                const bool first = (kt == 0) && (t == 0);
                if (first || __builtin_amdgcn_ballot_w64(mx > 8.f) != 0ull) {
                    mx = fmaxf(mx, __shfl_xor(mx, 32));
                    const float d = first ? mx : fmaxf(mx, 0.f);
                    const float alpha = first ? 1.f : __builtin_amdgcn_exp2f(-d);
                    m_run[u] += d; l_run[u] *= alpha;
#pragma unroll
                    for (int e = 0; e < 16; ++e) { o[u][0][e] *= alpha; o[u][1][e] *= alpha; x[u][e] -= d; }
                }
                f32x2 rs2; rs2.x = 0.f; rs2.y = 0.f;
#pragma unroll
                for (int e = 0; e < 16; e += 2) { x[u][e] = __builtin_amdgcn_exp2f(x[u][e]); x[u][e + 1] = __builtin_amdgcn_exp2f(x[u][e + 1]); f32x2 pv; pv.x = x[u][e]; pv.y = x[u][e + 1]; rs2 += pv; }
                l_run[u] += rs2.x + rs2.y;
#pragma unroll
                for (int s2 = 0; s2 < 2; ++s2) { pf[u][s2].u.x = pk(x[u][8 * s2], x[u][8 * s2 + 1]); pf[u][s2].u.y = pk(x[u][8 * s2 + 2], x[u][8 * s2 + 3]);
                    pf[u][s2].u.z = pk(x[u][8 * s2 + 4], x[u][8 * s2 + 5]); pf[u][s2].u.w = pk(x[u][8 * s2 + 6], x[u][8 * s2 + 7]); }
            }
#pragma unroll
            for (int s2 = 0; s2 < 2; ++s2) {
                const int kb = (32 * t + 16 * s2 + 4 * h) * 2;
                union { u32x4 u; bf16x8 b; } v0, v1;
                { const u32x2 a = *(const LAS u32x2*)(cV + c32 * VSTR + kb), b = *(const LAS u32x2*)(cV + c32 * VSTR + kb + 16); v0.u.x = a.x; v0.u.y = a.y; v0.u.z = b.x; v0.u.w = b.y; }
                { const u32x2 a = *(const LAS u32x2*)(cV + (32 + c32) * VSTR + kb), b = *(const LAS u32x2*)(cV + (32 + c32) * VSTR + kb + 16); v1.u.x = a.x; v1.u.y = a.y; v1.u.z = b.x; v1.u.w = b.y; }
                o[0][0] = mfma32(v0.b, pf[0][s2].b, o[0][0]); o[0][1] = mfma32(v1.b, pf[0][s2].b, o[0][1]);
                o[1][0] = mfma32(v0.b, pf[1][s2].b, o[1][0]); o[1][1] = mfma32(v1.b, pf[1][s2].b, o[1][1]);
            }
        }
        if (kt + 1 < nkt) {
            LAS unsigned char* nK = sK + (cur ^ 1) * 64 * KSTR; LAS unsigned char* nV = sV + (cur ^ 1) * 64 * VSTR;
            *(LAS u32x4*)(nK + ATT_KOFS(tl_)) = rk[0];
            if (tl_ < 256) *(LAS u32x4*)(nK + ATT_KOFS(tl_ + 512)) = rk[1];
            *(LAS u32x2*)(nV + ATT_VOFS(tl_)) = (u32x2){rv.x, rv.y}; *(LAS u32x2*)(nV + ATT_VOFS(tl_) + 8) = (u32x2){rv.z, rv.w};
        }
        __syncthreads();
    }
#pragma unroll
    for (int u = 0; u < 2; ++u) {
        const float l = l_run[u] + __shfl_xor(l_run[u], 32);
        const float inv = 1.f / l;
        bf16_t* orow = Ob + (size_t)(64 * w + 32 * u + c32) * 512;
        unsigned pv0[8], pv1[8];
#pragma unroll
        for (int g = 0; g < 4; ++g) {
            pv0[2 * g] = pk(o[u][0][4 * g] * inv, o[u][0][4 * g + 1] * inv); pv0[2 * g + 1] = pk(o[u][0][4 * g + 2] * inv, o[u][0][4 * g + 3] * inv);
            pv1[2 * g] = pk(o[u][1][4 * g] * inv, o[u][1][4 * g + 1] * inv); pv1[2 * g + 1] = pk(o[u][1][4 * g + 2] * inv, o[u][1][4 * g + 3] * inv);
        }
        store_row32(orow, pv0, h); store_row32(orow + 32, pv1, h);
    }
}

__device__ void phase_attn(const Params& p, LAS unsigned char* lds_) {
    int tid_ = threadIdx.x; asm volatile("" : "+v"(tid_)); const int half = tid_ >> 8, tid = tid_ & 255;
    LAS unsigned char* lds = lds_ + half * 65536;
    unsigned char* ws = p.ws;
    const int G = gridDim.x, bid = blockIdx.x;
    const int xcd = bid & 7, local = bid >> 3, nloc = (G - xcd + 7) >> 3;
    const bf16_t* Q = (const bf16_t*)(ws + OFF_Q); const bf16_t* Kp = (const bf16_t*)(ws + OFF_K); const bf16_t* VT = (const bf16_t*)(ws + OFF_VT); bf16_t* O = (bf16_t*)(ws + OFF_O);
    const int tid8 = tid_;
    for (int qt = local; qt < 32; qt += nloc) {
        const int head = xcd; const size_t base = (size_t)head * 16384;
        attn_item(tid8, lds_, Q + base * 96, Kp + base * 96, VT + base * 64, O + (size_t)(qt * 512) * 512 + head * 64, 16384, qt * 512);
    }
    for (int it = local; it < 64; it += nloc) {
        const int bh = xcd * 8 + (it >> 3), qt = it & 7, b = bh >> 3, head = bh & 7;
        const size_t ss = TP + (size_t)b * 4096; const size_t base = ss * 8 + (size_t)head * 4096;
        attn_item(tid8, lds_, Q + base * 96, Kp + base * 96, VT + base * 64, O + (ss + qt * 512) * 512 + head * 64, 4096, qt * 512);
    }
    __syncthreads();
    int tb_ = threadIdx.x; asm volatile("" : "+v"(tb_)); const int tidb = tb_ & 255, lane = tidb & 63, wid = tidb >> 6, wm = wid >> 1, wn = wid & 1, c32 = lane & 31, h = lane >> 5;
    const int lrow = tidb >> 3, lkc = (tidb & 7) ^ ((tidb >> 4) & 7);
    for (int t0 = bid * 2; t0 < 512 + 2048; t0 += G * 2) {
        const int tile = t0 + half;
        const bool prm = tile < 512; const int fb = prm ? tile : tile - 512;
        const int K = prm ? 256 : 128;
        const bf16_t* A = (const bf16_t*)(ws + (prm ? OFF_A2P : OFF_A2S)); const bf16_t* B = (const bf16_t*)(ws + (prm ? OFF_FB128 : OFF_FB64));
        unsigned ao[4], bo[4];
#pragma unroll
        for (int j = 0; j < 4; ++j) { const int i = lrow + 32 * j; ao[j] = (unsigned)(((size_t)fb * 128 + i) * K + lkc * 8); bo[j] = (unsigned)((size_t)i * K + lkc * 8); }
        f32x16 acc[2][2]; zero_acc(acc);
        gemm_core<false>(tidb, lds, A, ao, B, bo, K, acc);
        const int g = fb & 3; int k1, R; size_t ss; float scale;
        if (prm) { k1 = fb >> 2; R = 128; ss = 0; scale = 1.f / (128.f * 11.313708498984761f); }
        else { const int bk = fb >> 2; k1 = bk & 63; R = 64; ss = TP + (size_t)(bk >> 6) * 4096; scale = 1.f / (64.f * 11.313708498984761f); }
        if (prm || wn == 0) {
#pragma unroll
            for (int ni = 0; ni < 2; ++ni) {
                const int k2 = wn * 64 + ni * 32 + c32;
                bf16_t* frow = (bf16_t*)(ws + OFF_FB) + (ss + k1 + (size_t)R * k2) * 512 + g * 128;
#pragma unroll
                for (int mi = 0; mi < 2; ++mi)
#pragma unroll
                    for (int q = 0; q < 4; ++q) {
                        u32x2 w; w.x = pk(acc[mi][ni][4 * q] * scale, acc[mi][ni][4 * q + 1] * scale); w.y = pk(acc[mi][ni][4 * q + 2] * scale, acc[mi][ni][4 * q + 3] * scale);
                        *(u32x2*)(frow + wm * 64 + mi * 32 + 8 * q + 4 * h) = w;
                    }
            }
        }
    }
}

__device__ void phase_merge(const Params& p, LAS unsigned char* lds) {
    int tid_ = threadIdx.x; asm volatile("" : "+v"(tid_)); const int tid = tid_, lane = tid & 63, wid = tid >> 6, wm2 = wid >> 2, wn4 = wid & 3, c32 = lane & 31, h = lane >> 5;
    const int lrow = tid >> 2, lkc = (tid & 3) ^ ((tid >> 4) & 3);
    unsigned char* ws = p.ws;
    const bf16_t* Fb = (const bf16_t*)(ws + OFF_FB); const bf16_t* Ob = (const bf16_t*)(ws + OFF_O);
    const bf16_t* WF = (const bf16_t*)(ws + OFF_WF); const bf16_t* WA = (const bf16_t*)(ws + OFF_WAT);
    const bf16_t* gates = (const bf16_t*)p.out; bf16_t* MH = (bf16_t*)(ws + OFF_MH);
    int mt2, jt2;
    for (int it = 0; xcd_tile256(it, 4, mt2, jt2); ++it) {
        unsigned ao[4], bo[4];
#pragma unroll
        for (int j = 0; j < 4; ++j) { const int r = lrow + 128 * (j & 1); ao[j] = (unsigned)((size_t)(mt2 * 256 + r) * 512 + lkc * 8); bo[j] = (unsigned)((size_t)(jt2 * 256 + r) * 512 + lkc * 8); }
        f32x16 acc4[4][2]; zero_acc4(acc4);
        gemm_core256<true>(tid, lds, Fb, ao, WF, bo, 512, acc4);
        int le_ = lane; asm volatile("" : "+v"(le_));
#pragma unroll
        for (int mh = 0; mh < 2; ++mh) {
            const int c32 = le_ & 31, h = le_ >> 5;
            const int mt = 2 * mt2 + wm2, jt = 2 * jt2 + (wn4 >> 1), wm = mh, wn = wn4 & 1;
            f32x16 (&acc)[2][2] = reinterpret_cast<f32x16 (&)[2][2]>(acc4[2 * mh]);
#pragma unroll
        for (int mi = 0; mi < 2; ++mi) {
            const int tok = mt * 128 + wm * 64 + mi * 32 + c32;
#pragma unroll
            for (int ni = 0; ni < 2; ++ni) {
                unsigned pv[8], gq[8];
                load_row32(gates + (size_t)tok * 2048 + jt * 128 + wn * 64 + ni * 32, gq, h);
#pragma unroll
                for (int q = 0; q < 4; ++q) {
                    u32x2 gv; gv.x = gq[2 * q]; gv.y = gq[2 * q + 1];
                    pv[2 * q] = pk(acc[mi][ni][4 * q] * __uint_as_float(gv.x << 16), acc[mi][ni][4 * q + 1] * __uint_as_float(gv.x & 0xffff0000u));
                    pv[2 * q + 1] = pk(acc[mi][ni][4 * q + 2] * __uint_as_float(gv.y << 16), acc[mi][ni][4 * q + 3] * __uint_as_float(gv.y & 0xffff0000u));
                }
                store_row32(MH + (size_t)tok * 1024 + jt * 128 + wn * 64 + ni * 32, pv, h);
            }
        }
        }
        zero_acc4(acc4);
        gemm_core256<true>(tid, lds, Ob, ao, WA, bo, 512, acc4);
        le_ = lane; asm volatile("" : "+v"(le_));
#pragma unroll
        for (int mh = 0; mh < 2; ++mh) {
            const int c32 = le_ & 31, h = le_ >> 5;
            const int mt = 2 * mt2 + wm2, jt = 2 * jt2 + (wn4 >> 1), wm = mh, wn = wn4 & 1;
            f32x16 (&acc)[2][2] = reinterpret_cast<f32x16 (&)[2][2]>(acc4[2 * mh]);
#pragma unroll
        for (int mi = 0; mi < 2; ++mi) {
            const int tok = mt * 128 + wm * 64 + mi * 32 + c32;
#pragma unroll
            for (int ni = 0; ni < 2; ++ni) {
                unsigned pv[8], gq[8], mq[8];
                load_row32(gates + (size_t)tok * 2048 + 1024 + jt * 128 + wn * 64 + ni * 32, gq, h);
                load_row32(MH + (size_t)tok * 1024 + jt * 128 + wn * 64 + ni * 32, mq, h);
#pragma unroll
                for (int q = 0; q < 4; ++q) {
                    u32x2 gv; gv.x = gq[2 * q]; gv.y = gq[2 * q + 1];
                    u32x2 pm; pm.x = mq[2 * q]; pm.y = mq[2 * q + 1];
                    const float m0 = __uint_as_float(pm.x << 16) + acc[mi][ni][4 * q] * __uint_as_float(gv.x << 16), m1 = __uint_as_float(pm.x & 0xffff0000u) + acc[mi][ni][4 * q + 1] * __uint_as_float(gv.x & 0xffff0000u);
                    const float m2 = __uint_as_float(pm.y << 16) + acc[mi][ni][4 * q + 2] * __uint_as_float(gv.y << 16), m3 = __uint_as_float(pm.y & 0xffff0000u) + acc[mi][ni][4 * q + 3] * __uint_as_float(gv.y & 0xffff0000u);
                    pv[2 * q] = pk(m0, m1); pv[2 * q + 1] = pk(m2, m3);
                }
                store_row32(MH + (size_t)tok * 1024 + jt * 128 + wn * 64 + ni * 32, pv, h);
            }
        }
        }
    }
}

template <int WHICH>
__device__ void phase_resgemm(const Params& p, LAS unsigned char* lds) {
    int tid_ = threadIdx.x; asm volatile("" : "+v"(tid_)); const int tid = tid_, lane = tid & 63, wid = tid >> 6, wm2 = wid >> 2, wn4 = wid & 3, c32 = lane & 31, h = lane >> 5;
    const int lrow = tid >> 2, lkc = (tid & 3) ^ ((tid >> 4) & 3);
    unsigned char* ws = p.ws;
    const int K = WHICH == 0 ? 1024 : 2816;
    const bf16_t* A = (const bf16_t*)(ws + (WHICH == 0 ? OFF_MH : OFF_ACT)); const bf16_t* B = (const bf16_t*)(ws + (WHICH == 0 ? OFF_WO : OFF_WD));
    f32x2* st = (f32x2*)((float*)(ws + OFF_STATS) + (size_t)10 * T);
    int mt2, jt2;
    for (int it = 0; xcd_tile256(it, 4, mt2, jt2); ++it) {
        unsigned ao[4], bo[4];
#pragma unroll
        for (int j = 0; j < 4; ++j) { const int r = lrow + 128 * (j & 1); ao[j] = (unsigned)((size_t)(mt2 * 256 + r) * K + lkc * 8); bo[j] = (unsigned)((size_t)(jt2 * 256 + r) * K + lkc * 8); }
        f32x16 acc4[4][2]; zero_acc4(acc4);
        gemm_core256<true>(tid, lds, A, ao, B, bo, K, acc4);
        int le_ = lane; asm volatile("" : "+v"(le_));
        {
            LAS float* Tw = (LAS float*)(lds + (tid >> 6) * 16384);
            const int c32 = le_ & 31, h = le_ >> 5, g4 = le_ >> 4, c16 = le_ & 15;
            const int mt = 2 * mt2 + wm2, jt = 2 * jt2 + (wn4 >> 1), wn = wn4 & 1;
#pragma unroll
            for (int mh = 0; mh < 2; ++mh) {
#pragma unroll
                for (int mi = 0; mi < 2; ++mi)
#pragma unroll
                    for (int ni = 0; ni < 2; ++ni)
#pragma unroll
                        for (int q = 0; q < 4; ++q) {
                            const int row = mi * 32 + c32, chunk = (ni * 8 + 2 * q + h) ^ (row & 15);
                            f32x4 v; v[0] = acc4[2 * mh + mi][ni][4 * q]; v[1] = acc4[2 * mh + mi][ni][4 * q + 1]; v[2] = acc4[2 * mh + mi][ni][4 * q + 2]; v[3] = acc4[2 * mh + mi][ni][4 * q + 3];
                            *(LAS f32x4*)(Tw + row * 64 + chunk * 4) = v;
                        }
                const int tok0 = mt * 128 + mh * 64, col = jt * 128 + wn * 64 + 4 * c16;
#pragma unroll
                for (int p_ = 0; p_ < 16; ++p_) {
                    const int row = 4 * p_ + g4, tok = tok0 + row;
                    LAS float* cp = Tw + row * 64 + ((c16 ^ (row & 15)) * 4);
                    const f32x4 v = *(const LAS f32x4*)cp;
                    const float* res = WHICH == 0 ? xrow(p, tok) : p.out + (size_t)tok * 1024;
                    const f32x4 r = *(const f32x4*)(res + col);
                    f32x4 y; y[0] = ALPHA * r[0] + v[0]; y[1] = ALPHA * r[1] + v[1]; y[2] = ALPHA * r[2] + v[2]; y[3] = ALPHA * r[3] + v[3];
                    *(f32x4*)(p.out + (size_t)tok * 1024 + col) = y;
                    f32x2 sp; sp.x = (y[0] + y[1]) + (y[2] + y[3]); sp.y = (y[0] * y[0] + y[1] * y[1]) + (y[2] * y[2] + y[3] * y[3]);
                    *(LAS f32x2*)cp = sp;
                }
                {
                    const int row = le_; float s1 = 0.f, s2 = 0.f;
#pragma unroll
                    for (int j = 0; j < 16; ++j) { const f32x2 sp = *(const LAS f32x2*)(Tw + row * 64 + (((j + row) & 15) * 4)); s1 += sp.x; s2 += sp.y; }
                    f32x2 sv; sv.x = s1; sv.y = s2; st[(size_t)(tok0 + row) * 16 + jt * 2 + wn] = sv;
                }
            }
        }
        __syncthreads();
    }
}

template <int WHICH>
__device__ void phase_ln(const Params& p) {
    int tid_ = threadIdx.x; asm volatile("" : "+v"(tid_)); const int tid = tid_, lane = tid & 63, wid = tid >> 6;
    unsigned char* ws = p.ws;
    const f32x2* st = (const f32x2*)((const float*)(ws + OFF_STATS) + (size_t)10 * T);
    const float* gam = WHICH == 0 ? p.ln1_g : p.ln2_g; const float* bet = WHICH == 0 ? p.ln1_b : p.ln2_b;
    bf16_t* MH = (bf16_t*)(ws + OFF_MH);
    for (int row = blockIdx.x * 8 + wid; row < T; row += gridDim.x * 8) {
        const f32x2 pv = st[(size_t)row * 16 + (lane & 15)]; float s1 = pv.x, s2 = pv.y;
        s1 += __shfl_xor(s1, 8); s2 += __shfl_xor(s2, 8); s1 += __shfl_xor(s1, 4); s2 += __shfl_xor(s2, 4); s1 += __shfl_xor(s1, 2); s2 += __shfl_xor(s2, 2); s1 += __shfl_xor(s1, 1); s2 += __shfl_xor(s2, 1);
        const float mean = s1 * (1.f / 1024.f); const float var = fmaxf(s2 * (1.f / 1024.f) - mean * mean, 0.f); const float rstd = rsqrtf(var + 1e-5f);
        float* r = p.out + (size_t)row * 1024;
#pragma unroll
        for (int j = 0; j < 4; ++j) {
            const int col = j * 256 + lane * 4;
            const f32x4 v = *(const f32x4*)(r + col), g = *(const f32x4*)(gam + col), b = *(const f32x4*)(bet + col);
            f32x4 y; y[0] = (v[0] - mean) * rstd * g[0] + b[0]; y[1] = (v[1] - mean) * rstd * g[1] + b[1]; y[2] = (v[2] - mean) * rstd * g[2] + b[2]; y[3] = (v[3] - mean) * rstd * g[3] + b[3];
            if (WHICH == 1) __builtin_nontemporal_store(y, (f32x4*)(r + col)); else *(f32x4*)(r + col) = y;
            if (WHICH == 0) { u32x2 w; w.x = pk(y[0], y[1]); w.y = pk(y[2], y[3]); *(u32x2*)(MH + (size_t)row * 1024 + col) = w; }
        }
    }
}

__device__ void phase_ffn_up(const Params& p, LAS unsigned char* lds) {
    int tid_ = threadIdx.x; asm volatile("" : "+v"(tid_)); const int tid = tid_, lane = tid & 63, wid = tid >> 6, wm2 = wid >> 2, wn4 = wid & 3, c32 = lane & 31, h = lane >> 5;
    const int lrow = tid >> 2, lkc = (tid & 3) ^ ((tid >> 4) & 3);
    unsigned char* ws = p.ws;
    const bf16_t* A = (const bf16_t*)(ws + OFF_MH); const bf16_t* B = (const bf16_t*)(ws + OFF_WGU); bf16_t* ACT = (bf16_t*)(ws + OFF_ACT);
    int mt2, jt2;
    for (int it = 0; xcd_tile256(it, 22, mt2, jt2); ++it) {
        unsigned ao[4], bo[4];
#pragma unroll
        for (int j = 0; j < 4; ++j) { const int r = lrow + 128 * (j & 1); ao[j] = (unsigned)((size_t)(mt2 * 256 + r) * 1024 + lkc * 8); bo[j] = (unsigned)((size_t)(jt2 * 256 + r) * 1024 + lkc * 8); }
        f32x16 acc4[4][2]; zero_acc4(acc4);
        gemm_core256<true>(tid, lds, A, ao, B, bo, 1024, acc4);
        int le_ = lane; asm volatile("" : "+v"(le_));
#pragma unroll
        for (int mh = 0; mh < 2; ++mh) {
            const int c32 = le_ & 31, h = le_ >> 5;
            const int mt = 2 * mt2 + wm2, jt = 2 * jt2 + (wn4 >> 1), wm = mh, wn = wn4 & 1;
            f32x16 (&acc)[2][2] = reinterpret_cast<f32x16 (&)[2][2]>(acc4[2 * mh]);
#pragma unroll
        for (int mi = 0; mi < 2; ++mi) {
            const int tok = mt * 128 + wm * 64 + mi * 32 + c32;
            bf16_t* arow = ACT + (size_t)tok * 2816 + (jt * 2 + wn) * 32;
            unsigned pv[8];
#pragma unroll
            for (int q = 0; q < 4; ++q) {
                float v[4];
#pragma unroll
                for (int e = 0; e < 4; ++e) { const float g = acc[mi][0][4 * q + e], u = acc[mi][1][4 * q + e]; v[e] = g * u * __builtin_amdgcn_rcpf(1.f + __expf(-g)); }
                pv[2 * q] = pk(v[0], v[1]); pv[2 * q + 1] = pk(v[2], v[3]);
            }
            store_row32(arow, pv, h);
        }
        }
    }
}

__global__ void __launch_bounds__(512, 2) mega(Params p) {
    __shared__ __attribute__((aligned(16))) unsigned char smem[LDS_BYTES];
    LAS unsigned char* lds = (LAS unsigned char*)smem;
    cg::grid_group grid = cg::this_grid();
    const int lo = p.ph_lo, hi = p.ph_hi;
#if !defined(PHASE_MASK) || ((PHASE_MASK >> 0) & 1)
    if (lo <= 0 && 0 < hi) { phase_prep(p, lds);
#if defined(DUP_PHASE) && DUP_PHASE == 0
        grid.sync(); phase_prep(p, lds);
#endif
        if (0 + 1 < hi) grid.sync(); }
#endif
#if !defined(PHASE_MASK) || ((PHASE_MASK >> 1) & 1)
    if (lo <= 1 && 1 < hi) { phase_inproj(p, lds);
#if defined(DUP_PHASE) && DUP_PHASE == 1
        grid.sync(); phase_inproj(p, lds);
#endif
        if (1 + 1 < hi) grid.sync(); }
#endif
#ifdef EXP_CANARY
    { u32x4* q = (u32x4*)(p.ws + OFF_Q); const size_t n = (size_t)192 * MiB / 16; u32x4 v; v.x = v.y = v.z = v.w = 0x7fc07fc0u;
      int t_ = threadIdx.x; asm volatile("" : "+v"(t_));
      for (size_t i = (size_t)blockIdx.x * 256 + t_; i < n; i += (size_t)gridDim.x * 256) q[i] = v; grid.sync(); }
#endif
#if !defined(PHASE_MASK) || ((PHASE_MASK >> 2) & 1)
    if (lo <= 2 && 2 < hi) { phase_up(p, lds);
#if defined(DUP_PHASE) && DUP_PHASE == 2
        grid.sync(); phase_up(p, lds);
#endif
        if (2 + 1 < hi) grid.sync(); }
#endif
#ifdef EXP_CANARY
    { u32x4* q = (u32x4*)(p.ws + OFF_O); const size_t n = (size_t)48 * MiB / 16; u32x4 v; v.x = v.y = v.z = v.w = 0x7fc07fc0u;
      int t_ = threadIdx.x; asm volatile("" : "+v"(t_));
      for (size_t i = (size_t)blockIdx.x * 256 + t_; i < n; i += (size_t)gridDim.x * 256) q[i] = v; grid.sync(); }
#endif
#if !defined(PHASE_MASK) || ((PHASE_MASK >> 3) & 1)
    if (lo <= 3 && 3 < hi) { phase_attn(p, lds);
#if defined(DUP_PHASE) && DUP_PHASE == 3
        grid.sync(); phase_attn(p, lds);
#endif
        if (3 + 1 < hi) grid.sync(); }
#endif
#if !defined(PHASE_MASK) || ((PHASE_MASK >> 4) & 1)
    if (lo <= 4 && 4 < hi) { phase_merge(p, lds);
#if defined(DUP_PHASE) && DUP_PHASE == 4
        grid.sync(); phase_merge(p, lds);
#endif
        if (4 + 1 < hi) grid.sync(); }
#endif
#if !defined(PHASE_MASK) || ((PHASE_MASK >> 5) & 1)
    if (lo <= 5 && 5 < hi) { phase_resgemm<0>(p, lds);
#if defined(DUP_PHASE) && DUP_PHASE == 5
        grid.sync(); phase_resgemm<0>(p, lds);
#endif
        if (5 + 1 < hi) grid.sync(); }
#endif
#if !defined(PHASE_MASK) || ((PHASE_MASK >> 6) & 1)
    if (lo <= 6 && 6 < hi) { phase_ln<0>(p);
#if defined(DUP_PHASE) && DUP_PHASE == 6
        grid.sync(); phase_ln<0>(p);
#endif
        if (6 + 1 < hi) grid.sync(); }
#endif
#if !defined(PHASE_MASK) || ((PHASE_MASK >> 7) & 1)
    if (lo <= 7 && 7 < hi) { phase_ffn_up(p, lds);
#if defined(DUP_PHASE) && DUP_PHASE == 7
        grid.sync(); phase_ffn_up(p, lds);
#endif
        if (7 + 1 < hi) grid.sync(); }
#endif
#if !defined(PHASE_MASK) || ((PHASE_MASK >> 8) & 1)
    if (lo <= 8 && 8 < hi) { phase_resgemm<1>(p, lds);
#if defined(DUP_PHASE) && DUP_PHASE == 8
        grid.sync(); phase_resgemm<1>(p, lds);
#endif
        if (8 + 1 < hi) grid.sync(); }
#endif
#if !defined(PHASE_MASK) || ((PHASE_MASK >> 9) & 1)
    if (lo <= 9 && 9 < hi) { phase_ln<1>(p);
#if defined(DUP_PHASE) && DUP_PHASE == 9
        grid.sync(); phase_ln<1>(p);
#endif
        if (9 + 1 < hi) grid.sync(); }
#endif
}

extern "C" void kernel_launch(void* const* d_in, const int* in_sizes, int n_in, void* d_out, int out_size, void* d_ws, size_t ws_size, hipStream_t stream) {
    static int grid_blocks = 0;
    if (!grid_blocks) {
        int dev = 0, cus = 0, per_cu = 0;
        hipGetDevice(&dev);
        hipDeviceGetAttribute(&cus, hipDeviceAttributeMultiprocessorCount, dev);
        hipOccupancyMaxActiveBlocksPerMultiprocessor(&per_cu, mega, 512, 0);
        if (per_cu < 1) per_cu = 1;
        if (per_cu > 1) per_cu = 1;
        grid_blocks = cus * per_cu;
        if (ws_size < WS_END) { fprintf(stderr, "kernel_launch: workspace too small: %zu < %zu\n", ws_size, (size_t)WS_END); grid_blocks = -1; }
    }
    if (grid_blocks < 0) return;
    Params p{};
    p.x_prompt = (const float*)d_in[0]; p.x_sample = (const float*)d_in[1]; p.w_in = (const float*)d_in[2]; p.w_fourier = (const float*)d_in[3];
    p.g_q = (const float*)d_in[4]; p.w_uq = (const float*)d_in[5]; p.g_kv = (const float*)d_in[6]; p.w_ukv = (const float*)d_in[7];
    p.w_attn = (const float*)d_in[8]; p.w_o = (const float*)d_in[9]; p.ln1_g = (const float*)d_in[10]; p.ln1_b = (const float*)d_in[11];
    p.w_gate = (const float*)d_in[12]; p.w_up = (const float*)d_in[13]; p.w_down = (const float*)d_in[14]; p.ln2_g = (const float*)d_in[15]; p.ln2_b = (const float*)d_in[16];
    p.out = (float*)d_out; p.ws = (unsigned char*)d_ws;
#if COOP
    p.ph_lo = 0; p.ph_hi = NPHASE;
    void* args[] = {&p};
    hipError_t e = hipLaunchCooperativeKernel((void*)mega, dim3(grid_blocks), dim3(512), args, 0, stream);
    if (e != hipSuccess) fprintf(stderr, "cooperative launch failed: %s (grid %d)\n", hipGetErrorString(e), grid_blocks);
#else
    for (int ph = 0; ph < NPHASE; ++ph) {
        p.ph_lo = ph; p.ph_hi = ph + 1;
        hipLaunchKernelGGL(mega, dim3(grid_blocks), dim3(512), 0, stream, p);
    }
#endif
}
```

```cpp
#include <hip/hip_runtime.h>
#include <hip/hip_cooperative_groups.h>
#include <stdint.h>
#include <stdio.h>
namespace cg = cooperative_groups;

#ifndef COOP
#define COOP 1
#endif

#define LAS __attribute__((address_space(3)))
typedef unsigned short bf16_t;
typedef short bf16x8 __attribute__((ext_vector_type(8)));
typedef float f32x16 __attribute__((ext_vector_type(16)));
typedef float f32x4 __attribute__((ext_vector_type(4)));
typedef float f32x2 __attribute__((ext_vector_type(2)));
typedef unsigned u32x4 __attribute__((ext_vector_type(4)));
typedef unsigned u32x2 __attribute__((ext_vector_type(2)));

constexpr int T = 49152, TP = 16384;
constexpr size_t MiB = (size_t)1 << 20;
constexpr size_t OFF_W1P = 0, OFF_W1S = 32 * MiB, OFF_FB = 0, OFF_O = 48 * MiB, OFF_XB = 96 * MiB, OFF_Q = 96 * MiB, OFF_K = 168 * MiB,
                 OFF_VT = 240 * MiB, OFF_A2P = 288 * MiB, OFF_A2S = 320 * MiB, OFF_MH = 96 * MiB, OFF_ACT = 192 * MiB, OFF_CQ = 384 * MiB,
                 OFF_CKV = 420 * MiB, OFF_KPE = 444 * MiB, OFF_WT = 456 * MiB;
constexpr size_t OFF_WIN = OFF_WT;
constexpr size_t OFF_WF = OFF_WIN + (size_t)3840 * 1024 * 2;
constexpr size_t OFF_WAT = OFF_WF + (size_t)1024 * 512 * 2;
constexpr size_t OFF_WO = OFF_WAT + (size_t)1024 * 512 * 2;
constexpr size_t OFF_WGU = OFF_WO + (size_t)1024 * 1024 * 2;
constexpr size_t OFF_WD = OFF_WGU + (size_t)5632 * 1024 * 2;
constexpr size_t OFF_WUQ = OFF_WD + (size_t)1024 * 2816 * 2;
constexpr size_t OFF_WUKV = OFF_WUQ + (size_t)768 * 384 * 2;
constexpr size_t OFF_FA128 = OFF_WUKV + (size_t)1024 * 256 * 2;
constexpr size_t OFF_FA64 = OFF_FA128 + (size_t)256 * 256 * 2;
constexpr size_t OFF_FB128 = OFF_FA64 + (size_t)128 * 128 * 2;
constexpr size_t OFF_FB64 = OFF_FB128 + (size_t)128 * 256 * 2;
constexpr size_t OFF_ROPE = OFF_FB64 + (size_t)128 * 128 * 2;
constexpr size_t OFF_STATS = OFF_ROPE + (size_t)16384 * 16 * 8;
constexpr size_t WS_END = OFF_STATS + ((size_t)42 * T) * 4;

constexpr int GSTR = 144;
constexpr int KSTR = 208, VSTR = 136;
constexpr int LDS_BYTES = 131072;
constexpr float ALPHA = 1.189207115002721f;
constexpr float QSCALE = 0.10206207261596575f * 1.4426950408889634f;
constexpr int NPHASE = 10;

struct Params {
    const float *x_prompt, *x_sample, *w_in, *w_fourier, *g_q, *w_uq, *g_kv, *w_ukv, *w_attn, *w_o, *ln1_g, *ln1_b, *w_gate, *w_up, *w_down, *ln2_g, *ln2_b;
    float* out; unsigned char* ws; int ph_lo, ph_hi;
};

__device__ const double INVFREQ_D[16] = {1.0, 0.5623413251903491, 0.31622776601683794, 0.1778279410038923, 0.1, 0.05623413251903491, 0.03162277660168379, 0.01778279410038923,
                                         0.01, 0.005623413251903491, 0.0031622776601683794, 0.001778279410038923, 0.001, 0.0005623413251903491, 0.00031622776601683794, 0.0001778279410038923};

typedef __bf16 bf16x2_t __attribute__((ext_vector_type(2)));
__device__ __forceinline__ unsigned pk(float lo, float hi) { f32x2 v; v.x = lo; v.y = hi; const bf16x2_t b = __builtin_convertvector(v, bf16x2_t); return __builtin_bit_cast(unsigned, b); }
__device__ __forceinline__ void store_row32(bf16_t* base, const unsigned (&pv)[8], int h) {
#pragma unroll
    for (int k = 0; k < 4; k += 2) {
        unsigned ax = pv[2 * k], ay = pv[2 * k + 1], bx = pv[2 * k + 2], by = pv[2 * k + 3];
        { auto r_ = __builtin_amdgcn_permlane32_swap(ax, bx, false, false); ax = r_[0]; bx = r_[1]; }
        { auto r_ = __builtin_amdgcn_permlane32_swap(ay, by, false, false); ay = r_[0]; by = r_[1]; }
        u32x4 w; w.x = ax; w.y = ay; w.z = bx; w.w = by;
        *(u32x4*)(base + 8 * k + 8 * h) = w;
    }
}
__device__ __forceinline__ void load_row32(const bf16_t* base, unsigned (&pv)[8], int h) {
#pragma unroll
    for (int k = 0; k < 4; k += 2) {
        const u32x4 w = *(const u32x4*)(base + 8 * k + 8 * h);
        unsigned ax = w.x, ay = w.y, bx = w.z, by = w.w;
        { auto r_ = __builtin_amdgcn_permlane32_swap(ax, bx, false, false); ax = r_[0]; bx = r_[1]; }
        { auto r_ = __builtin_amdgcn_permlane32_swap(ay, by, false, false); ay = r_[0]; by = r_[1]; }
        pv[2 * k] = ax; pv[2 * k + 1] = ay; pv[2 * k + 2] = bx; pv[2 * k + 3] = by;
    }
}
__device__ __forceinline__ float cos_rev(float r) { return __builtin_amdgcn_cosf(r); }
__device__ __forceinline__ float sin_rev(float r) { return __builtin_amdgcn_sinf(r); }
__device__ __forceinline__ float bf2f(unsigned short v) { return __uint_as_float((unsigned)v << 16); }
__device__ __forceinline__ f32x16 mfma32(bf16x8 a, bf16x8 b, f32x16 c) { return __builtin_amdgcn_mfma_f32_32x32x16_bf16(a, b, c, 0, 0, 0); }
__device__ __forceinline__ void tok_info(int t, int& seq_start, int& S, int& pos) {
    if (t < TP) { seq_start = 0; S = 16384; pos = t; } else { const int u = t - TP; seq_start = TP + (u & ~4095); S = 4096; pos = u & 4095; }
}
__device__ __forceinline__ const float* xrow(const Params& p, int tok) { return tok < TP ? p.x_prompt + (size_t)tok * 1024 : p.x_sample + (size_t)(tok - TP) * 1024; }
__device__ __forceinline__ void zero_acc(f32x16 (&acc)[2][2]) {
#pragma unroll
    for (int a = 0; a < 2; ++a)
#pragma unroll
        for (int b = 0; b < 2; ++b)
#pragma unroll
            for (int e = 0; e < 16; ++e) acc[a][b][e] = 0.f;
}

template <bool SWAP>
__device__ __forceinline__ void gemm_core(const int tid, LAS unsigned char* lds, const bf16_t* __restrict__ Ab, const unsigned (&ao)[4], const bf16_t* __restrict__ Bb, const unsigned (&bo)[4], int K, f32x16 (&acc)[2][2]) {
    const int lane = tid & 63, wid = tid >> 6, wm = wid >> 1, wn = wid & 1;
    const int w = __builtin_amdgcn_readfirstlane(wid);
    const int c32 = lane & 31, t3 = (lane >> 5) ^ ((c32 >> 1) & 7);
    const int aoff = (wm * 64 + c32) * 128 + t3 * 16;
    const int boff = 16384 + (wn * 64 + c32) * 128 + t3 * 16;
    const int nk = K >> 6;
#define GEMM_ISSUE(kt_, buf_) do { _Pragma("unroll") for (int j_ = 0; j_ < 4; ++j_) { \
        __builtin_amdgcn_global_load_lds((const unsigned*)(Ab + (ao[j_] + (unsigned)(kt_) * 64u)), (LAS unsigned*)(lds + (buf_) * 32768 + (w + 4 * j_) * 1024), 16, 0, 0); \
        __builtin_amdgcn_global_load_lds((const unsigned*)(Bb + (bo[j_] + (unsigned)(kt_) * 64u)), (LAS unsigned*)(lds + (buf_) * 32768 + 16384 + (w + 4 * j_) * 1024), 16, 0, 0); } } while (0)
    GEMM_ISSUE(0, 0);
#pragma unroll 1
    for (int kt = 0; kt < nk; ++kt) {
        asm volatile("s_waitcnt vmcnt(0)" ::: "memory");
        __syncthreads();
        if (kt + 1 < nk) GEMM_ISSUE(kt + 1, (kt + 1) & 1);
        LAS unsigned char* sb = lds + (kt & 1) * 32768;
        bf16x8 fa[2][2], fb[2][2];
        fa[0][0] = *(const LAS bf16x8*)(sb + aoff); fa[0][1] = *(const LAS bf16x8*)(sb + aoff + 32 * 128);
        fb[0][0] = *(const LAS bf16x8*)(sb + boff); fb[0][1] = *(const LAS bf16x8*)(sb + boff + 32 * 128);
#pragma unroll
        for (int kk = 0; kk < 4; ++kk) {
            const int c = kk & 1, n = c ^ 1;
            if (kk < 3) {
                fa[n][0] = *(const LAS bf16x8*)(sb + (aoff ^ ((kk + 1) * 32))); fa[n][1] = *(const LAS bf16x8*)(sb + ((aoff + 32 * 128) ^ ((kk + 1) * 32)));
                fb[n][0] = *(const LAS bf16x8*)(sb + (boff ^ ((kk + 1) * 32))); fb[n][1] = *(const LAS bf16x8*)(sb + ((boff + 32 * 128) ^ ((kk + 1) * 32)));
            }
            if (SWAP) { acc[0][0] = mfma32(fb[c][0], fa[c][0], acc[0][0]); acc[0][1] = mfma32(fb[c][1], fa[c][0], acc[0][1]); acc[1][0] = mfma32(fb[c][0], fa[c][1], acc[1][0]); acc[1][1] = mfma32(fb[c][1], fa[c][1], acc[1][1]); }
            else      { acc[0][0] = mfma32(fa[c][0], fb[c][0], acc[0][0]); acc[0][1] = mfma32(fa[c][0], fb[c][1], acc[0][1]); acc[1][0] = mfma32(fa[c][1], fb[c][0], acc[1][0]); acc[1][1] = mfma32(fa[c][1], fb[c][1], acc[1][1]); }
        }
    }
#undef GEMM_ISSUE
    __syncthreads();
}

__device__ __forceinline__ bool xcd_tile(int it, int NT, int& mt, int& jt) {
    const int G = gridDim.x, b = blockIdx.x;
    if (G & 7) { const int tile = b + it * G; if (tile >= 384 * NT) return false; mt = tile / NT; jt = tile - mt * NT; return true; }
    const int xcd = b & 7, local = b >> 3, nloc = G >> 3;
    const int o = local + it * nloc; if (o >= 48 * NT) return false;
    const int pw = 8 * NT, pnl = o / pw, idx = o - pnl * pw;
    jt = idx >> 3; mt = 48 * xcd + 8 * pnl + (idx & 7); return true;
}

__device__ __forceinline__ void zero_acc4(f32x16 (&acc)[4][2]) {
#pragma unroll
    for (int a = 0; a < 4; ++a)
#pragma unroll
        for (int b = 0; b < 2; ++b)
#pragma unroll
            for (int e = 0; e < 16; ++e) acc[a][b][e] = 0.f;
}
template <bool SWAP>
__device__ __forceinline__ void gemm_core256(const int tid, LAS unsigned char* lds, const bf16_t* __restrict__ Ab, const unsigned (&ao)[4], const bf16_t* __restrict__ Bb, const unsigned (&bo)[4], int K, f32x16 (&acc)[4][2]) {
    const int lane = tid & 63, wid = tid >> 6, wm = wid >> 2, wn = wid & 3;
    const int w = __builtin_amdgcn_readfirstlane(wid);
    const int grp = w >> 2;
    const int c32 = lane & 31, t2 = (lane >> 5) ^ ((c32 >> 2) & 3);
    const int aoff = (wm * 128 + c32) * 64 + t2 * 16;
    const int boff = 16384 + (wn * 64 + c32) * 64 + t2 * 16;
    const int nk = K >> 5;
#define G256_ISSUE1(j_, kt_, buf_) do { \
        __builtin_amdgcn_global_load_lds((const unsigned*)(Ab + (ao[j_] + (unsigned)(kt_) * 32u)), (LAS unsigned*)(lds + (buf_) * 32768 + (w + 8 * (j_)) * 1024), 16, 0, 0); \
        __builtin_amdgcn_global_load_lds((const unsigned*)(Bb + (bo[j_] + (unsigned)(kt_) * 32u)), (LAS unsigned*)(lds + (buf_) * 32768 + 16384 + (w + 8 * (j_)) * 1024), 16, 0, 0); } while (0)
#define G256_BAR do { asm volatile("" ::: "memory"); __builtin_amdgcn_s_barrier(); asm volatile("" ::: "memory"); } while (0)
#define G256_SB __builtin_amdgcn_sched_barrier(0)
#define G256_LDA do { _Pragma("unroll") for (int i_ = 0; i_ < 4; ++i_) _Pragma("unroll") for (int k_ = 0; k_ < 2; ++k_) \
        fa[i_][k_] = *(const LAS bf16x8*)(sb + ((aoff + i_ * 32 * 64) ^ (k_ * 32))); } while (0)
#define G256_LDB do { _Pragma("unroll") for (int n_ = 0; n_ < 2; ++n_) _Pragma("unroll") for (int k_ = 0; k_ < 2; ++k_) \
        fb[n_][k_] = *(const LAS bf16x8*)(sb + ((boff + n_ * 32 * 64) ^ (k_ * 32))); } while (0)
#define G256_MMA do { _Pragma("unroll") for (int k_ = 0; k_ < 2; ++k_) _Pragma("unroll") for (int i_ = 0; i_ < 4; ++i_) _Pragma("unroll") for (int n_ = 0; n_ < 2; ++n_) { \
        if (SWAP) acc[i_][n_] = mfma32(fb[n_][k_], fa[i_][k_], acc[i_][n_]); else acc[i_][n_] = mfma32(fa[i_][k_], fb[n_][k_], acc[i_][n_]); } \
        } while (0)
#define G256_ENDL do { asm volatile("s_waitcnt lgkmcnt(0)" ::: "memory"); G256_SB; G256_BAR; G256_SB; } while (0)
    G256_ISSUE1(0, 0, 0); G256_ISSUE1(1, 0, 0);
    if (nk > 1) { G256_ISSUE1(0, 1, 1); G256_ISSUE1(1, 1, 1); asm volatile("s_waitcnt vmcnt(4)" ::: "memory"); }
    else asm volatile("s_waitcnt vmcnt(0)" ::: "memory");
    G256_BAR;
    if (grp == 1) G256_BAR;
#pragma unroll 1
    for (int kt = 0; kt < nk; ++kt) {
        LAS unsigned char* sb = lds + (kt & 3) * 32768; const int nb = (kt + 2) & 3; const bool more2 = kt + 2 < nk;
        bf16x8 fa[4][2], fb[2][2];
        G256_SB; G256_LDA; G256_LDB;
        if (more2) { G256_ISSUE1(0, kt + 2, nb); G256_ISSUE1(1, kt + 2, nb); asm volatile("s_waitcnt vmcnt(4)" ::: "memory"); } else asm volatile("s_waitcnt vmcnt(0)" ::: "memory");
        G256_ENDL;
        G256_MMA; G256_SB; G256_BAR; G256_SB;
    }
    if (grp == 0) G256_BAR;
#undef G256_ENDL
#undef G256_MMA
#undef G256_LDB
#undef G256_LDA
#undef G256_SB
#undef G256_BAR
#undef G256_ISSUE1
}

__device__ __forceinline__ bool xcd_tile256(int it, int NT, int& mt, int& jt) {
    const int G = gridDim.x, b = blockIdx.x;
    if (G & 7) { const int tile = b + it * G; if (tile >= 192 * NT) return false; mt = tile / NT; jt = tile - mt * NT; return true; }
    const int xcd = b & 7, local = b >> 3, nloc = G >> 3;
    const int o = local + it * nloc; if (o >= 24 * NT) return false;
    const int pw = 4 * NT, pnl = o / pw, idx = o - pnl * pw;
    jt = idx >> 2; mt = 24 * xcd + 4 * pnl + (idx & 3); return true;
}

template <class F>
__device__ __forceinline__ void transpose_job(const int tid, const int half, LAS unsigned char* lds, bf16_t* dst, int K, int N, F f) {
    LAS float* tl = (LAS float*)lds;
    const int ntn = N >> 6, ntk = K >> 6, nt = ntn * ntk;
    for (int t0 = blockIdx.x * 2; t0 < nt; t0 += gridDim.x * 2) {
        const int tile = (t0 + half < nt) ? t0 + half : nt - 1;
        const int n0 = (tile / ntk) << 6, k0 = (tile % ntk) << 6;
        __syncthreads();
#pragma unroll 4
        for (int r = 0; r < 16; ++r) { const int kl = (tid >> 6) + 4 * r, nl = tid & 63; tl[kl * 65 + nl] = f(k0 + kl, n0 + nl); }
        __syncthreads();
        const int nl = tid >> 2, kq = tid & 3;
        u32x4 w0, w1;
        w0.x = pk(tl[(kq * 16 + 0) * 65 + nl], tl[(kq * 16 + 1) * 65 + nl]); w0.y = pk(tl[(kq * 16 + 2) * 65 + nl], tl[(kq * 16 + 3) * 65 + nl]);
        w0.z = pk(tl[(kq * 16 + 4) * 65 + nl], tl[(kq * 16 + 5) * 65 + nl]); w0.w = pk(tl[(kq * 16 + 6) * 65 + nl], tl[(kq * 16 + 7) * 65 + nl]);
        w1.x = pk(tl[(kq * 16 + 8) * 65 + nl], tl[(kq * 16 + 9) * 65 + nl]); w1.y = pk(tl[(kq * 16 + 10) * 65 + nl], tl[(kq * 16 + 11) * 65 + nl]);
        w1.z = pk(tl[(kq * 16 + 12) * 65 + nl], tl[(kq * 16 + 13) * 65 + nl]); w1.w = pk(tl[(kq * 16 + 14) * 65 + nl], tl[(kq * 16 + 15) * 65 + nl]);
        bf16_t* d = dst + (size_t)(n0 + nl) * K + k0 + kq * 16;
        *(u32x4*)d = w0; *(u32x4*)(d + 8) = w1;
    }
    __syncthreads();
}

__device__ void phase_prep(const Params& p, LAS unsigned char* lds_) {
    int tid_ = threadIdx.x; asm volatile("" : "+v"(tid_)); const int half = tid_ >> 8, tid = tid_ & 255, bid = blockIdx.x * 2 + half, gsz = gridDim.x * 2;
    LAS unsigned char* lds = lds_ + half * 65536;
    const size_t gtid = (size_t)bid * 256 + tid, gth = (size_t)gsz * 256;
    unsigned char* ws = p.ws;
#ifdef EXP_CANARY
    { u32x4 v; v.x = v.y = v.z = v.w = 0x7fc07fc0u;
      u32x4* a = (u32x4*)(ws + OFF_CQ); for (size_t i = gtid; i < (size_t)63 * MiB / 16; i += gth) a[i] = v;
      u32x4* b = (u32x4*)(ws + OFF_STATS); for (size_t i = gtid; i < (size_t)42 * T * 4 / 16; i += gth) b[i] = v;
      u32x4* c = (u32x4*)p.out; for (size_t i = gtid; i < (size_t)192 * MiB / 16; i += gth) c[i] = v; }
#endif
    { bf16_t* xb = (bf16_t*)(ws + OFF_XB);
      for (size_t i = gtid; i < (size_t)T * 1024 / 8; i += gth) {
          const size_t e = i * 8; const float* src = (e < (size_t)TP * 1024) ? p.x_prompt + e : p.x_sample + (e - (size_t)TP * 1024);
          const f32x4 a = *(const f32x4*)src, b = *(const f32x4*)(src + 4);
          u32x4 w; w.x = pk(a[0], a[1]); w.y = pk(a[2], a[3]); w.z = pk(b[0], b[1]); w.w = pk(b[2], b[3]);
          *(u32x4*)(xb + e) = w; } }
    { f32x2* rope = (f32x2*)(ws + OFF_ROPE);
      for (size_t i = gtid; i < (size_t)16384 * 16; i += gth) {
          const int s = (int)(i >> 4), j = (int)(i & 15); const float invf = (float)INVFREQ_D[j]; const float ang = (float)s * invf;
          double rev = (double)ang * 0.15915494309189535; rev -= floor(rev); const float r = (float)rev;
          f32x2 v; v.x = cos_rev(r); v.y = sin_rev(r); rope[i] = v; } }
    { bf16_t* fa = (bf16_t*)(ws + OFF_FA128);
      for (size_t i = gtid; i < (size_t)256 * 256; i += gth) { const int n = (int)(i >> 8), k = (int)(i & 255); const int ro = (n >> 5) & 1, k1 = (n >> 6) * 32 + (n & 31), n1 = k >> 1, ri = k & 1;
          const float r = (float)((k1 * n1) & 127) * (1.f / 128.f); const float c = cos_rev(r), s = sin_rev(r); const float v = ro == 0 ? (ri == 0 ? c : s) : (ri == 0 ? -s : c);
          fa[i] = (bf16_t)(pk(v, 0.f) & 0xffff); }
      bf16_t* fa6 = (bf16_t*)(ws + OFF_FA64);
      for (size_t i = gtid; i < (size_t)128 * 128; i += gth) { const int n = (int)(i >> 7), k = (int)(i & 127); const int ro = (n >> 5) & 1, k1 = (n >> 6) * 32 + (n & 31), n1 = k >> 1, ri = k & 1;
          const float r = (float)((k1 * n1) & 63) * (1.f / 64.f); const float c = cos_rev(r), s = sin_rev(r); const float v = ro == 0 ? (ri == 0 ? c : s) : (ri == 0 ? -s : c);
          fa6[i] = (bf16_t)(pk(v, 0.f) & 0xffff); }
      bf16_t* fb = (bf16_t*)(ws + OFF_FB128);
      for (size_t i = gtid; i < (size_t)128 * 256; i += gth) { const int k2 = (int)(i >> 8), k = (int)(i & 255); const int n2 = k >> 1, ri = k & 1;
          const float r = (float)((k2 * n2) & 127) * (1.f / 128.f); const float v = ri == 0 ? cos_rev(r) : sin_rev(r); fb[i] = (bf16_t)(pk(v, 0.f) & 0xffff); }
      bf16_t* fb6 = (bf16_t*)(ws + OFF_FB64);
      for (size_t i = gtid; i < (size_t)128 * 128; i += gth) { const int k2 = (int)(i >> 7), k = (int)(i & 127); const int n2 = k >> 1, ri = k & 1;
          const float r = (float)((k2 * n2) & 63) * (1.f / 64.f); float v = ri == 0 ? cos_rev(r) : sin_rev(r); if (k2 >= 64) v = 0.f; fb6[i] = (bf16_t)(pk(v, 0.f) & 0xffff); } }
    { LAS float* cs = (LAS float*)lds; LAS float* sn = cs + 128;
      __syncthreads();
      if (tid < 128) { const float r = (float)tid * (1.f / 128.f); cs[tid] = cos_rev(r); sn[tid] = sin_rev(r); }
      __syncthreads();
      bf16_t* wt = (bf16_t*)(ws + OFF_WIN);
      for (int it = bid; it < 1024 * 4; it += gsz) {
          const int k = it >> 2, n = (it & 3) * 256 + tid;
          const int jt = n >> 7, cl = n & 127, g = jt >> 1, hf = jt & 1, sub = cl >> 5, cc = cl & 31, wn = sub >> 1, reim = sub & 1, cp = hf * 64 + wn * 32 + cc;
          const float* wr = p.w_in + (size_t)k * 3232 + g * 128;
          float acc = 0.f;
          for (int c = 0; c < 128; c += 4) {
              const f32x4 w4 = *(const f32x4*)(wr + c);
#pragma unroll
              for (int e = 0; e < 4; ++e) { const int idx = ((c + e) * cp) & 127; const float tw = reim ? -sn[idx] : cs[idx]; acc += w4[e] * tw; }
          }
          wt[(size_t)n * 1024 + k] = (bf16_t)(pk(acc, 0.f) & 0xffff);
      }
      __syncthreads(); }
    { const float* w_in = p.w_in;
      transpose_job(tid, half, lds, (bf16_t*)(ws + OFF_WIN) + (size_t)1024 * 1024, 1024, 2816, [=](int k, int n) -> float {
          int src; if (n < 384) src = 512 + n; else if (n < 640) src = 896 + (n - 384); else if (n < 768) src = (n - 640 < 32) ? 1152 + (n - 640) : -1; else src = 1184 + (n - 768);
          return src >= 0 ? w_in[(size_t)k * 3232 + src] : 0.f; }); }
    { const float* w = p.w_fourier; transpose_job(tid, half, lds, (bf16_t*)(ws + OFF_WF), 512, 1024, [=](int k, int n) -> float { return w[(size_t)k * 1024 + n]; }); }
    { const float* w = p.w_attn; transpose_job(tid, half, lds, (bf16_t*)(ws + OFF_WAT), 512, 1024, [=](int k, int n) -> float { return w[(size_t)k * 1024 + n]; }); }
    { const float* w = p.w_o; transpose_job(tid, half, lds, (bf16_t*)(ws + OFF_WO), 1024, 1024, [=](int k, int n) -> float { return w[(size_t)k * 1024 + n]; }); }
    { const float* wg = p.w_gate; const float* wu = p.w_up;
      transpose_job(tid, half, lds, (bf16_t*)(ws + OFF_WGU), 1024, 5632, [=](int k, int n) -> float { const int grp = n >> 6, r = n & 63; return r < 32 ? wg[(size_t)k * 2816 + grp * 32 + r] : wu[(size_t)k * 2816 + grp * 32 + r - 32]; }); }
    { const float* w = p.w_down; transpose_job(tid, half, lds, (bf16_t*)(ws + OFF_WD), 2816, 1024, [=](int k, int n) -> float { return w[(size_t)k * 1024 + n]; }); }
    { const float* w = p.w_uq; const float* g = p.g_q; transpose_job(tid, half, lds, (bf16_t*)(ws + OFF_WUQ), 384, 768, [=](int k, int n) -> float { return w[(size_t)k * 768 + n] * g[k]; }); }
    { const float* w = p.w_ukv; const float* g = p.g_kv;
      transpose_job(tid, half, lds, (bf16_t*)(ws + OFF_WUKV), 256, 1024, [=](int k, int n) -> float { const int col = n < 512 ? (n >> 6) * 128 + (n & 63) : ((n - 512) >> 6) * 128 + 64 + (n & 63); return w[(size_t)k * 1024 + col] * g[k]; }); }
}

__device__ __forceinline__ int p1_token(int mt, int i) {
    if (mt < 128) return 128 * i + mt;
    const int idx = mt - 128, b = idx >> 5, pr = idx & 31;
    return TP + b * 4096 + 64 * (i & 63) + 2 * pr + (i >> 6);
}

__device__ void phase_inproj(const Params& p, LAS unsigned char* lds) {
    int tid_ = threadIdx.x; asm volatile("" : "+v"(tid_)); const int tid = tid_, lane = tid & 63, wid = tid >> 6, wm2 = wid >> 2, wn4 = wid & 3, c32 = lane & 31, h = lane >> 5;
    const int lrow = tid >> 2, lkc = (tid & 3) ^ ((tid >> 4) & 3);
    unsigned char* ws = p.ws;
    const bf16_t* xb = (const bf16_t*)(ws + OFF_XB); const bf16_t* wt = (const bf16_t*)(ws + OFF_WIN);
    float* stats = (float*)(ws + OFF_STATS);
    int mt2, jt2;
    for (int it = 0; xcd_tile256(it, 15, mt2, jt2); ++it) {
        unsigned ao[4], bo[4];
#pragma unroll
        for (int j = 0; j < 4; ++j) { const int r = lrow + 128 * (j & 1); ao[j] = (unsigned)((size_t)p1_token(2 * mt2 + (r >> 7), r & 127) * 1024 + lkc * 8); bo[j] = (unsigned)((size_t)(jt2 * 256 + r) * 1024 + lkc * 8); }
        f32x16 acc4[4][2]; zero_acc4(acc4);
        if (jt2 < 4) gemm_core256<false>(tid, lds, xb, ao, wt, bo, 1024, acc4); else gemm_core256<true>(tid, lds, xb, ao, wt, bo, 1024, acc4);
        int le_ = lane; asm volatile("" : "+v"(le_));
#pragma unroll
        for (int mh = 0; mh < 2; ++mh) {
            const int c32 = le_ & 31, h = le_ >> 5;
            const int mt = 2 * mt2 + wm2, jt = 2 * jt2 + (wn4 >> 1), wm = mh, wn = wn4 & 1;
            f32x16 (&acc)[2][2] = reinterpret_cast<f32x16 (&)[2][2]>(acc4[2 * mh]);
        if (jt < 8) {
            const int cp = (jt & 1) * 64 + wn * 32 + c32, ch = (jt >> 1) * 128 + cp;
#pragma unroll
            for (int mi = 0; mi < 2; ++mi)
#pragma unroll
                for (int q = 0; q < 4; ++q) {
                    const int i0 = wm * 64 + mi * 32 + 8 * q + 4 * h;
                    bf16_t* dst;
                    if (mt < 128) dst = (bf16_t*)(ws + OFF_W1P) + (((size_t)ch * 128 + mt) * 128 + i0) * 2;
                    else { const int idx = mt - 128, b = idx >> 5, pr = idx & 31; dst = (bf16_t*)(ws + OFF_W1S) + ((((size_t)b * 512 + ch) * 64 + 2 * pr + (i0 >> 6)) * 64 + (i0 & 63)) * 2; }
                    u32x4 w; w.x = pk(acc[mi][0][4 * q], acc[mi][1][4 * q]); w.y = pk(acc[mi][0][4 * q + 1], acc[mi][1][4 * q + 1]);
                    w.z = pk(acc[mi][0][4 * q + 2], acc[mi][1][4 * q + 2]); w.w = pk(acc[mi][0][4 * q + 3], acc[mi][1][4 * q + 3]);
                    *(u32x4*)dst = w;
                }
        } else {
#pragma unroll
            for (int mi = 0; mi < 2; ++mi) {
                const int tok = p1_token(mt, wm * 64 + mi * 32 + c32);
                if (jt < 13) {
                    const bool isq = jt < 11; bf16_t* dstrow = isq ? (bf16_t*)(ws + OFF_CQ) + (size_t)tok * 384 + (jt - 8) * 128 : (bf16_t*)(ws + OFF_CKV) + (size_t)tok * 256 + (jt - 11) * 128;
                    float ss = 0.f;
#pragma unroll
                    for (int ni = 0; ni < 2; ++ni) {
                        unsigned pv[8];
#pragma unroll
                        for (int q = 0; q < 4; ++q) {
                            const float v0 = acc[mi][ni][4 * q], v1 = acc[mi][ni][4 * q + 1], v2 = acc[mi][ni][4 * q + 2], v3 = acc[mi][ni][4 * q + 3];
                            ss += v0 * v0 + v1 * v1 + v2 * v2 + v3 * v3;
                            pv[2 * q] = pk(v0, v1); pv[2 * q + 1] = pk(v2, v3);
                        }
                        store_row32(dstrow + wn * 64 + ni * 32, pv, h);
                    }
                    ss += __shfl_xor(ss, 32);
                    if (h == 0) { if (isq) stats[(size_t)tok * 6 + (jt - 8) * 2 + wn] = ss; else stats[(size_t)6 * T + (size_t)tok * 4 + (jt - 11) * 2 + wn] = ss; }
                } else if (jt == 13) {
                    if (wn == 0) {
                        int ss_, S_, pos; tok_info(tok, ss_, S_, pos);
                        const f32x2* rope = (const f32x2*)(ws + OFF_ROPE) + (size_t)pos * 16;
                        bf16_t* dstrow = (bf16_t*)(ws + OFF_KPE) + (size_t)tok * 32;
#pragma unroll
                        for (int q = 0; q < 2; ++q) {
                            const int j0 = 8 * q + 4 * h;
                            float o1[4], o2[4];
#pragma unroll
                            for (int e = 0; e < 4; ++e) { const f32x2 cs = rope[j0 + e]; const float x1 = acc[mi][0][4 * q + e], x2 = acc[mi][0][4 * (q + 2) + e]; o1[e] = x1 * cs.x - x2 * cs.y; o2[e] = x2 * cs.x + x1 * cs.y; }
                            u32x2 w; w.x = pk(o1[0], o1[1]); w.y = pk(o1[2], o1[3]); *(u32x2*)(dstrow + j0) = w;
                            w.x = pk(o2[0], o2[1]); w.y = pk(o2[2], o2[3]); *(u32x2*)(dstrow + 16 + j0) = w;
                        }
                    }
                } else {
                    bf16_t* dstrow = (bf16_t*)p.out + (size_t)tok * 2048 + (jt - 14) * 128;
#pragma unroll
                    for (int ni = 0; ni < 2; ++ni) {
                        unsigned pv[8];
#pragma unroll
                        for (int q = 0; q < 4; ++q) {
                            float v[4];
#pragma unroll
                            for (int e = 0; e < 4; ++e) v[e] = __builtin_amdgcn_rcpf(1.f + __expf(-acc[mi][ni][4 * q + e]));
                            pv[2 * q] = pk(v[0], v[1]); pv[2 * q + 1] = pk(v[2], v[3]);
                        }
                        store_row32(dstrow + wn * 64 + ni * 32, pv, h);
                    }
                }
            }
        }
        }
    }
}

__device__ void phase_up(const Params& p, LAS unsigned char* lds_) {
    unsigned char* ws = p.ws;
    const float* stats = (const float*)(ws + OFF_STATS);
    {
        int t8_ = threadIdx.x; asm volatile("" : "+v"(t8_)); const int tid8 = t8_, lane8 = tid8 & 63, wid8 = tid8 >> 6, wm2 = wid8 >> 2, wn4 = wid8 & 3;
        const int lrow8 = tid8 >> 2, lkc8 = (tid8 & 3) ^ ((tid8 >> 4) & 3);
        for (int tile = blockIdx.x; tile < 576 + 768; tile += gridDim.x) {
            unsigned ao[4], bo[4];
            f32x16 acc4[4][2]; zero_acc4(acc4);
            if (tile < 576) {
                const int mt2 = tile / 3, jt2 = tile - mt2 * 3;
                const bf16_t* A = (const bf16_t*)(ws + OFF_CQ); const bf16_t* B = (const bf16_t*)(ws + OFF_WUQ);
#pragma unroll
                for (int j = 0; j < 4; ++j) { const int r = lrow8 + 128 * (j & 1); ao[j] = (unsigned)((size_t)(mt2 * 256 + r) * 384 + lkc8 * 8); bo[j] = (unsigned)((size_t)(jt2 * 256 + r) * 384 + lkc8 * 8); }
                gemm_core256<true>(tid8, lds_, A, ao, B, bo, 384, acc4);
        int le_ = lane8; asm volatile("" : "+v"(le_));
#pragma unroll
        for (int mh = 0; mh < 2; ++mh) {
            const int c32 = le_ & 31, h = le_ >> 5;
            const int mt = 2 * mt2 + wm2, jt = 2 * jt2 + (wn4 >> 1), wm = mh, wn = wn4 & 1;
            f32x16 (&acc)[2][2] = reinterpret_cast<f32x16 (&)[2][2]>(acc4[2 * mh]);
#pragma unroll
            for (int mi = 0; mi < 2; ++mi) {
                const int tok = mt * 128 + wm * 64 + mi * 32 + c32; int ss_, S_, pos; tok_info(tok, ss_, S_, pos);
                const f32x2 pa = *(const f32x2*)(stats + (size_t)tok * 6), pb = *(const f32x2*)(stats + (size_t)tok * 6 + 2), pc = *(const f32x2*)(stats + (size_t)tok * 6 + 4);
                const float rs = rsqrtf((((pa.x + pa.y) + (pb.x + pb.y)) + (pc.x + pc.y)) * (1.f / 384.f) + 1e-6f) * QSCALE;
#pragma unroll
                for (int ni = 0; ni < 2; ++ni) {
                    const int nt = jt * 4 + wn * 2 + ni, head = nt / 3, part = nt - 3 * head;
                    bf16_t* qd = (bf16_t*)(ws + OFF_Q) + ((size_t)ss_ * 8 + (size_t)head * S_ + pos) * 96;
                    if (part < 2) {
                        unsigned pv[8];
#pragma unroll
                        for (int q = 0; q < 4; ++q) { pv[2 * q] = pk(acc[mi][ni][4 * q] * rs, acc[mi][ni][4 * q + 1] * rs); pv[2 * q + 1] = pk(acc[mi][ni][4 * q + 2] * rs, acc[mi][ni][4 * q + 3] * rs); }
                        store_row32(qd + part * 32, pv, h);
                    } else {
                        const f32x2* rope = (const f32x2*)(ws + OFF_ROPE) + (size_t)pos * 16;
#pragma unroll
                        for (int q = 0; q < 2; ++q) {
                            const int j0 = 8 * q + 4 * h; float o1[4], o2[4];
#pragma unroll
                            for (int e = 0; e < 4; ++e) { const f32x2 cs = rope[j0 + e]; const float x1 = acc[mi][ni][4 * q + e] * rs, x2 = acc[mi][ni][4 * (q + 2) + e] * rs; o1[e] = x1 * cs.x - x2 * cs.y; o2[e] = x2 * cs.x + x1 * cs.y; }
                            u32x2 w; w.x = pk(o1[0], o1[1]); w.y = pk(o1[2], o1[3]); *(u32x2*)(qd + 64 + j0) = w;
                            w.x = pk(o2[0], o2[1]); w.y = pk(o2[2], o2[3]); *(u32x2*)(qd + 80 + j0) = w;
                        }
                    }
                }
            }
        }
            } else {
                const int t2 = tile - 576, mt2 = t2 >> 2, jt2 = t2 & 3;
                const bf16_t* A = (const bf16_t*)(ws + OFF_CKV); const bf16_t* B = (const bf16_t*)(ws + OFF_WUKV);
#pragma unroll
                for (int j = 0; j < 4; ++j) { const int r = lrow8 + 128 * (j & 1); ao[j] = (unsigned)((size_t)(mt2 * 256 + r) * 256 + lkc8 * 8); bo[j] = (unsigned)((size_t)(jt2 * 256 + r) * 256 + lkc8 * 8); }
                if (jt2 < 2) {
                    gemm_core256<true>(tid8, lds_, A, ao, B, bo, 256, acc4);
        int le_ = lane8; asm volatile("" : "+v"(le_));
#pragma unroll
        for (int mh = 0; mh < 2; ++mh) {
            const int c32 = le_ & 31, h = le_ >> 5;
            const int mt = 2 * mt2 + wm2, jt = 2 * jt2 + (wn4 >> 1), wm = mh, wn = wn4 & 1;
            f32x16 (&acc)[2][2] = reinterpret_cast<f32x16 (&)[2][2]>(acc4[2 * mh]);
                const int head = 2 * jt + wn;
#pragma unroll
                for (int mi = 0; mi < 2; ++mi) {
                    const int tok = mt * 128 + wm * 64 + mi * 32 + c32; int ss_, S_, pos; tok_info(tok, ss_, S_, pos);
                    const f32x4 pv = *(const f32x4*)(stats + (size_t)6 * T + (size_t)tok * 4);
                    const float rs = rsqrtf(((pv[0] + pv[1]) + (pv[2] + pv[3])) * (1.f / 256.f) + 1e-6f);
                    bf16_t* kd = (bf16_t*)(ws + OFF_K) + ((size_t)ss_ * 8 + (size_t)head * S_ + pos) * 96;
#pragma unroll
                    for (int ni = 0; ni < 2; ++ni) {
                        unsigned pv[8];
#pragma unroll
                        for (int q = 0; q < 4; ++q) { pv[2 * q] = pk(acc[mi][ni][4 * q] * rs, acc[mi][ni][4 * q + 1] * rs); pv[2 * q + 1] = pk(acc[mi][ni][4 * q + 2] * rs, acc[mi][ni][4 * q + 3] * rs); }
                        store_row32(kd + ni * 32, pv, h);
                    }
                }
        }
                } else {
                    gemm_core256<false>(tid8, lds_, A, ao, B, bo, 256, acc4);
        int le_ = lane8; asm volatile("" : "+v"(le_));
#pragma unroll
        for (int mh = 0; mh < 2; ++mh) {
            const int c32 = le_ & 31, h = le_ >> 5;
            const int mt = 2 * mt2 + wm2, jt = 2 * jt2 + (wn4 >> 1), wm = mh, wn = wn4 & 1;
            f32x16 (&acc)[2][2] = reinterpret_cast<f32x16 (&)[2][2]>(acc4[2 * mh]);
                const int head = 2 * (jt - 4) + wn;
#pragma unroll
                for (int mi = 0; mi < 2; ++mi)
#pragma unroll
                    for (int q = 0; q < 4; ++q) {
                        const int tok0 = mt * 128 + wm * 64 + mi * 32 + 8 * q + 4 * h; int ss_, S_, pos; tok_info(tok0, ss_, S_, pos);
                        const float* sp = stats + (size_t)6 * T + (size_t)tok0 * 4;
                        const f32x4 q0 = *(const f32x4*)sp, q1 = *(const f32x4*)(sp + 4), q2 = *(const f32x4*)(sp + 8), q3 = *(const f32x4*)(sp + 12);
                        const float r0 = rsqrtf(((q0[0] + q0[1]) + (q0[2] + q0[3])) * (1.f / 256.f) + 1e-6f), r1 = rsqrtf(((q1[0] + q1[1]) + (q1[2] + q1[3])) * (1.f / 256.f) + 1e-6f), r2 = rsqrtf(((q2[0] + q2[1]) + (q2[2] + q2[3])) * (1.f / 256.f) + 1e-6f), r3 = rsqrtf(((q3[0] + q3[1]) + (q3[2] + q3[3])) * (1.f / 256.f) + 1e-6f);
#pragma unroll
                        for (int ni = 0; ni < 2; ++ni) {
                            const int d = ni * 32 + c32;
                            bf16_t* vd = (bf16_t*)(ws + OFF_VT) + ((size_t)ss_ * 8 + (size_t)head * S_) * 64 + (size_t)d * S_ + pos;
                            u32x2 w; w.x = pk(acc[mi][ni][4 * q] * r0, acc[mi][ni][4 * q + 1] * r1); w.y = pk(acc[mi][ni][4 * q + 2] * r2, acc[mi][ni][4 * q + 3] * r3);
                            *(u32x2*)vd = w;
                        }
                    }
        }
                }
            }
        }
    }
    int tid_ = threadIdx.x; asm volatile("" : "+v"(tid_)); const int half = tid_ >> 8, tid = tid_ & 255, lane = tid & 63, wid = tid >> 6, wm = wid >> 1, wn = wid & 1, c32 = lane & 31, h = lane >> 5;
    const int lrow = tid >> 3, lkc = (tid & 7) ^ ((tid >> 4) & 7);
    LAS unsigned char* lds = lds_ + half * 65536;
    const int NQ = 0, NKV = 0, NFP = 1024, NFS = 2048, NTOT = NFP + NFS;
    for (int t0 = blockIdx.x * 2; t0 < NTOT; t0 += gridDim.x * 2) {
        const int tile = t0 + half;
        unsigned ao[4], bo[4];
        f32x16 acc[2][2]; zero_acc(acc);
        {
            const int t3 = tile - NQ - NKV; const bool prm = t3 < NFP;
            int K, jn, rowtile; const bf16_t* A; const bf16_t* B;
            if (prm) { rowtile = t3 >> 1; jn = t3 & 1; K = 256; A = (const bf16_t*)(ws + OFF_W1P); B = (const bf16_t*)(ws + OFF_FA128); }
            else { rowtile = t3 - NFP; jn = 0; K = 128; A = (const bf16_t*)(ws + OFF_W1S); B = (const bf16_t*)(ws + OFF_FA64); }
#pragma unroll
            for (int j = 0; j < 4; ++j) { const int i = lrow + 32 * j; ao[j] = (unsigned)(((size_t)rowtile * 128 + i) * K + lkc * 8); bo[j] = (unsigned)((size_t)(jn * 128 + i) * K + lkc * 8); }
            gemm_core<false>(tid, lds, A, ao, B, bo, K, acc);
            const int k1 = (jn * 2 + wn) * 32 + c32;
#pragma unroll
            for (int mi = 0; mi < 2; ++mi)
#pragma unroll
                for (int q = 0; q < 4; ++q) {
                    const int i0 = wm * 64 + mi * 32 + 8 * q + 4 * h;
                    int n2b; bf16_t* dst; float invS;
                    if (prm) { n2b = i0; dst = (bf16_t*)(ws + OFF_A2P) + (((size_t)k1 * 512 + rowtile) * 128 + n2b) * 2; invS = 1.f / 16384.f; }
                    else { const int b = rowtile >> 8, ch = 2 * (rowtile & 255) + (i0 >> 6); n2b = i0 & 63; dst = (bf16_t*)(ws + OFF_A2S) + ((((size_t)b * 64 + k1) * 512 + ch) * 64 + n2b) * 2; invS = 1.f / 4096.f; }
                    u32x4 w; unsigned wv[4];
#pragma unroll
                    for (int e = 0; e < 4; ++e) {
                        const float rev = (float)(k1 * (n2b + e)) * invS; const float c = cos_rev(rev), s = sin_rev(rev);
                        const float re = acc[mi][0][4 * q + e], im = acc[mi][1][4 * q + e];
                        wv[e] = pk(re * c + im * s, im * c - re * s);
                    }
                    w.x = wv[0]; w.y = wv[1]; w.z = wv[2]; w.w = wv[3];
                    *(u32x4*)dst = w;
                }
        }
    }
    { const size_t gtid = ((size_t)blockIdx.x * 2 + half) * 256 + tid, gth = (size_t)gridDim.x * 512;
      const bf16_t* kpe = (const bf16_t*)(ws + OFF_KPE); bf16_t* Kb = (bf16_t*)(ws + OFF_K);
      for (size_t i = gtid; i < (size_t)T * 32; i += gth) {
          const int c = (int)(i & 3), hh = (int)((i >> 2) & 7), tok = (int)(i >> 5); int ss_, S_, pos; tok_info(tok, ss_, S_, pos);
          const u32x4 v = *(const u32x4*)(kpe + (size_t)tok * 32 + c * 8);
          *(u32x4*)(Kb + ((size_t)ss_ * 8 + (size_t)hh * S_ + pos) * 96 + 64 + c * 8) = v; } }
}

__device__ __forceinline__ void attn_item(const int tid, LAS unsigned char* lds, const bf16_t* __restrict__ Qb, const bf16_t* __restrict__ Kb, const bf16_t* __restrict__ Vb, bf16_t* __restrict__ Ob, int S, int q0) {
    const int lane = tid & 63, w = tid >> 6, c32 = lane & 31, h = lane >> 5;
    bf16x8 qf[2][6];
#pragma unroll
    for (int u = 0; u < 2; ++u) { const bf16_t* qp = Qb + (size_t)(q0 + 64 * w + 32 * u + c32) * 96 + h * 8;
#pragma unroll
      for (int kk = 0; kk < 6; ++kk) qf[u][kk] = *(const bf16x8*)(qp + kk * 16); }
    f32x16 o[2][2];
#pragma unroll
    for (int u = 0; u < 2; ++u)
#pragma unroll
        for (int d = 0; d < 2; ++d)
#pragma unroll
            for (int e = 0; e < 16; ++e) o[u][d][e] = 0.f;
    float m_run[2] = {0.f, 0.f}, l_run[2] = {0.f, 0.f};
    LAS unsigned char* sK = lds; LAS unsigned char* sV = lds + 2 * 64 * KSTR;
    const int nkt = S >> 6;
    u32x4 rk[2], rv;
    rk[1].x = rk[1].y = rk[1].z = rk[1].w = 0u;
#define ATT_KOFS(c_) (((c_) / 12) * KSTR + ((c_) % 12) * 16)
#define ATT_VOFS(c_) (((c_) >> 3) * VSTR + ((c_) & 7) * 16)
#define ATT_VSRC(c_) ((unsigned)((c_) >> 3) * (unsigned)S + (unsigned)(((c_) & 7) * 8))
    rk[0] = *(const u32x4*)(Kb + (size_t)tid * 8);
    if (tid < 256) rk[1] = *(const u32x4*)(Kb + (size_t)(tid + 512) * 8);
    rv = *(const u32x4*)(Vb + ATT_VSRC(tid));
    __syncthreads();
    *(LAS u32x4*)(sK + ATT_KOFS(tid)) = rk[0];
    if (tid < 256) *(LAS u32x4*)(sK + ATT_KOFS(tid + 512)) = rk[1];
    *(LAS u32x2*)(sV + ATT_VOFS(tid)) = (u32x2){rv.x, rv.y}; *(LAS u32x2*)(sV + ATT_VOFS(tid) + 8) = (u32x2){rv.z, rv.w};
    __syncthreads();
#pragma unroll 1
    for (int kt = 0; kt < nkt; ++kt) {
        const int cur = kt & 1;
        LAS unsigned char* cK = sK + cur * 64 * KSTR; LAS unsigned char* cV = sV + cur * 64 * VSTR;
        int tl_ = tid; asm volatile("" : "+v"(tl_));
#pragma unroll
        for (int t = 0; t < 2; ++t) {
            f32x16 x[2];
#pragma unroll
            for (int u = 0; u < 2; ++u)
#pragma unroll
                for (int e = 0; e < 16; ++e) x[u][e] = -m_run[u];
#pragma unroll
            for (int kk = 0; kk < 6; ++kk) {
                const bf16x8 kf = *(const LAS bf16x8*)(cK + (32 * t + c32) * KSTR + kk * 32 + h * 16);
                x[0] = mfma32(kf, qf[0][kk], x[0]); x[1] = mfma32(kf, qf[1][kk], x[1]);
            }
            if (t == 0) {
                __builtin_amdgcn_sched_barrier(0);
                if (kt + 1 < nkt) {
                    rk[0] = *(const u32x4*)(Kb + (size_t)(kt + 1) * 64 * 96 + (size_t)tl_ * 8);
                    if (tl_ < 256) rk[1] = *(const u32x4*)(Kb + (size_t)(kt + 1) * 64 * 96 + (size_t)(tl_ + 512) * 8);
                    rv = *(const u32x4*)(Vb + ATT_VSRC(tl_) + (size_t)(kt + 1) * 64);
                }
            }
            union PF { u32x4 u; bf16x8 b; } pf[2][2];
#pragma unroll
            for (int u = 0; u < 2; ++u) {
                float mx = fmaxf(fmaxf(x[u][0], x[u][1]), x[u][2]);
#pragma unroll
                for (int e = 3; e < 15; e += 2) mx = fmaxf(fmaxf(mx, x[u][e]), x[u][e + 1]);
                mx = fmaxf(mx, x[u][15]);
                const bool first = (kt == 0) && (t == 0);
                if (first || __builtin_amdgcn_ballot_w64(mx > 8.f) != 0ull) {
                    mx = fmaxf(mx, __shfl_xor(mx, 32));
                    const float d = first ? mx : fmaxf(mx, 0.f);
                    const float alpha = first ? 1.f : __builtin_amdgcn_exp2f(-d);
                    m_run[u] += d; l_run[u] *= alpha;
#pragma unroll
                    for (int e = 0; e < 16; ++e) { o[u][0][e] *= alpha; o[u][1][e] *= alpha; x[u][e] -= d; }
                }
                f32x2 rs2; rs2.x = 0.f; rs2.y = 0.f;
#pragma unroll
                for (int e = 0; e < 16; e += 2) { x[u][e] = __builtin_amdgcn_exp2f(x[u][e]); x[u][e + 1] = __builtin_amdgcn_exp2f(x[u][e + 1]); f32x2 pv; pv.x = x[u][e]; pv.y = x[u][e + 1]; rs2 += pv; }
                l_run[u] += rs2.x + rs2.y;
#pragma unroll
                for (int s2 = 0; s2 < 2; ++s2) { pf[u][s2].u.x = pk(x[u][8 * s2], x[u][8 * s2 + 1]); pf[u][s2].u.y = pk(x[u][8 * s2 + 2], x[u][8 * s2 + 3]);
                    pf[u][s2].u.z = pk(x[u][8 * s2 + 4], x[u][8 * s2 + 5]); pf[u][s2].u.w = pk(x[u][8 * s2 + 6], x[u][8 * s2 + 7]); }
            }
#pragma unroll
            for (int s2 = 0; s2 < 2; ++s2) {
                const int kb = (32 * t + 16 * s2 + 4 * h) * 2;
                union { u32x4 u; bf16x8 b; } v0, v1;
                { const u32x2 a = *(const LAS u32x2*)(cV + c32 * VSTR + kb), b = *(const LAS u32x2*)(cV + c32 * VSTR + kb + 16); v0.u.x = a.x; v0.u.y = a.y; v0.u.z = b.x; v0.u.w = b.y; }
                { const u32x2 a = *(const LAS u32x2*)(cV + (32 + c32) * VSTR + kb), b = *(const LAS u32x2*)(cV + (32 + c32) * VSTR + kb + 16); v1.u.x = a.x; v1.u.y = a.y; v1.u.z = b.x; v1.u.w = b.y; }
                o[0][0] = mfma32(v0.b, pf[0][s2].b, o[0][0]); o[0][1] = mfma32(v1.b, pf[0][s2].b, o[0][1]);
                o[1][0] = mfma32(v0.b, pf[1][s2].b, o[1][0]); o[1][1] = mfma32(v1.b, pf[1][s2].b, o[1][1]);
            }
        }
        if (kt + 1 < nkt) {
            LAS unsigned char* nK = sK + (cur ^ 1) * 64 * KSTR; LAS unsigned char* nV = sV + (cur ^ 1) * 64 * VSTR;
            *(LAS u32x4*)(nK + ATT_KOFS(tl_)) = rk[0];
            if (tl_ < 256) *(LAS u32x4*)(nK + ATT_KOFS(tl_ + 512)) = rk[1];
            *(LAS u32x2*)(nV + ATT_VOFS(tl_)) = (u32x2){rv.x, rv.y}; *(LAS u32x2*)(nV + ATT_VOFS(tl_) + 8) = (u32x2){rv.z, rv.w};
        }
        __syncthreads();
    }
#pragma unroll
    for (int u = 0; u < 2; ++u) {
        const float l = l_run[u] + __shfl_xor(l_run[u], 32);
        const float inv = 1.f / l;
        bf16_t* orow = Ob + (size_t)(64 * w + 32 * u + c32) * 512;
        unsigned pv0[8], pv1[8];
#pragma unroll
        for (int g = 0; g < 4; ++g) {
            pv0[2 * g] = pk(o[u][0][4 * g] * inv, o[u][0][4 * g + 1] * inv); pv0[2 * g + 1] = pk(o[u][0][4 * g + 2] * inv, o[u][0][4 * g + 3] * inv);
            pv1[2 * g] = pk(o[u][1][4 * g] * inv, o[u][1][4 * g + 1] * inv); pv1[2 * g + 1] = pk(o[u][1][4 * g + 2] * inv, o[u][1][4 * g + 3] * inv);
        }
        store_row32(orow, pv0, h); store_row32(orow + 32, pv1, h);
    }
}

__device__ void phase_attn(const Params& p, LAS unsigned char* lds_) {
    int tid_ = threadIdx.x; asm volatile("" : "+v"(tid_)); const int half = tid_ >> 8, tid = tid_ & 255;
    LAS unsigned char* lds = lds_ + half * 65536;
    unsigned char* ws = p.ws;
    const int G = gridDim.x, bid = blockIdx.x;
    const int xcd = bid & 7, local = bid >> 3, nloc = (G - xcd + 7) >> 3;
    const bf16_t* Q = (const bf16_t*)(ws + OFF_Q); const bf16_t* Kp = (const bf16_t*)(ws + OFF_K); const bf16_t* VT = (const bf16_t*)(ws + OFF_VT); bf16_t* O = (bf16_t*)(ws + OFF_O);
    const int tid8 = tid_;
    for (int qt = local; qt < 32; qt += nloc) {
        const int head = xcd; const size_t base = (size_t)head * 16384;
        attn_item(tid8, lds_, Q + base * 96, Kp + base * 96, VT + base * 64, O + (size_t)(qt * 512) * 512 + head * 64, 16384, qt * 512);
    }
    for (int it = local; it < 64; it += nloc) {
        const int bh = xcd * 8 + (it >> 3), qt = it & 7, b = bh >> 3, head = bh & 7;
        const size_t ss = TP + (size_t)b * 4096; const size_t base = ss * 8 + (size_t)head * 4096;
        attn_item(tid8, lds_, Q + base * 96, Kp + base * 96, VT + base * 64, O + (ss + qt * 512) * 512 + head * 64, 4096, qt * 512);
    }
    __syncthreads();
    int tb_ = threadIdx.x; asm volatile("" : "+v"(tb_)); const int tidb = tb_ & 255, lane = tidb & 63, wid = tidb >> 6, wm = wid >> 1, wn = wid & 1, c32 = lane & 31, h = lane >> 5;
    const int lrow = tidb >> 3, lkc = (tidb & 7) ^ ((tidb >> 4) & 7);
    for (int t0 = bid * 2; t0 < 512 + 2048; t0 += G * 2) {
        const int tile = t0 + half;
        const bool prm = tile < 512; const int fb = prm ? tile : tile - 512;
        const int K = prm ? 256 : 128;
        const bf16_t* A = (const bf16_t*)(ws + (prm ? OFF_A2P : OFF_A2S)); const bf16_t* B = (const bf16_t*)(ws + (prm ? OFF_FB128 : OFF_FB64));
        unsigned ao[4], bo[4];
#pragma unroll
        for (int j = 0; j < 4; ++j) { const int i = lrow + 32 * j; ao[j] = (unsigned)(((size_t)fb * 128 + i) * K + lkc * 8); bo[j] = (unsigned)((size_t)i * K + lkc * 8); }
        f32x16 acc[2][2]; zero_acc(acc);
        gemm_core<false>(tidb, lds, A, ao, B, bo, K, acc);
        const int g = fb & 3; int k1, R; size_t ss; float scale;
        if (prm) { k1 = fb >> 2; R = 128; ss = 0; scale = 1.f / (128.f * 11.313708498984761f); }
        else { const int bk = fb >> 2; k1 = bk & 63; R = 64; ss = TP + (size_t)(bk >> 6) * 4096; scale = 1.f / (64.f * 11.313708498984761f); }
        if (prm || wn == 0) {
#pragma unroll
            for (int ni = 0; ni < 2; ++ni) {
                const int k2 = wn * 64 + ni * 32 + c32;
                bf16_t* frow = (bf16_t*)(ws + OFF_FB) + (ss + k1 + (size_t)R * k2) * 512 + g * 128;
#pragma unroll
                for (int mi = 0; mi < 2; ++mi)
#pragma unroll
                    for (int q = 0; q < 4; ++q) {
                        u32x2 w; w.x = pk(acc[mi][ni][4 * q] * scale, acc[mi][ni][4 * q + 1] * scale); w.y = pk(acc[mi][ni][4 * q + 2] * scale, acc[mi][ni][4 * q + 3] * scale);
                        *(u32x2*)(frow + wm * 64 + mi * 32 + 8 * q + 4 * h) = w;
                    }
            }
        }
    }
}

__device__ void phase_merge(const Params& p, LAS unsigned char* lds) {
    int tid_ = threadIdx.x; asm volatile("" : "+v"(tid_)); const int tid = tid_, lane = tid & 63, wid = tid >> 6, wm2 = wid >> 2, wn4 = wid & 3, c32 = lane & 31, h = lane >> 5;
    const int lrow = tid >> 2, lkc = (tid & 3) ^ ((tid >> 4) & 3);
    unsigned char* ws = p.ws;
    const bf16_t* Fb = (const bf16_t*)(ws + OFF_FB); const bf16_t* Ob = (const bf16_t*)(ws + OFF_O);
    const bf16_t* WF = (const bf16_t*)(ws + OFF_WF); const bf16_t* WA = (const bf16_t*)(ws + OFF_WAT);
    const bf16_t* gates = (const bf16_t*)p.out; bf16_t* MH = (bf16_t*)(ws + OFF_MH);
    int mt2, jt2;
    for (int it = 0; xcd_tile256(it, 4, mt2, jt2); ++it) {
        unsigned ao[4], bo[4];
#pragma unroll
        for (int j = 0; j < 4; ++j) { const int r = lrow + 128 * (j & 1); ao[j] = (unsigned)((size_t)(mt2 * 256 + r) * 512 + lkc * 8); bo[j] = (unsigned)((size_t)(jt2 * 256 + r) * 512 + lkc * 8); }
        f32x16 acc4[4][2]; zero_acc4(acc4);
        gemm_core256<true>(tid, lds, Fb, ao, WF, bo, 512, acc4);
        int le_ = lane; asm volatile("" : "+v"(le_));
#pragma unroll
        for (int mh = 0; mh < 2; ++mh) {
            const int c32 = le_ & 31, h = le_ >> 5;
            const int mt = 2 * mt2 + wm2, jt = 2 * jt2 + (wn4 >> 1), wm = mh, wn = wn4 & 1;
            f32x16 (&acc)[2][2] = reinterpret_cast<f32x16 (&)[2][2]>(acc4[2 * mh]);
#pragma unroll
        for (int mi = 0; mi < 2; ++mi) {
            const int tok = mt * 128 + wm * 64 + mi * 32 + c32;
#pragma unroll
            for (int ni = 0; ni < 2; ++ni) {
                unsigned pv[8], gq[8];
                load_row32(gates + (size_t)tok * 2048 + jt * 128 + wn * 64 + ni * 32, gq, h);
#pragma unroll
                for (int q = 0; q < 4; ++q) {
                    u32x2 gv; gv.x = gq[2 * q]; gv.y = gq[2 * q + 1];
                    pv[2 * q] = pk(acc[mi][ni][4 * q] * __uint_as_float(gv.x << 16), acc[mi][ni][4 * q + 1] * __uint_as_float(gv.x & 0xffff0000u));
                    pv[2 * q + 1] = pk(acc[mi][ni][4 * q + 2] * __uint_as_float(gv.y << 16), acc[mi][ni][4 * q + 3] * __uint_as_float(gv.y & 0xffff0000u));
                }
                store_row32(MH + (size_t)tok * 1024 + jt * 128 + wn * 64 + ni * 32, pv, h);
            }
        }
        }
        zero_acc4(acc4);
        gemm_core256<true>(tid, lds, Ob, ao, WA, bo, 512, acc4);
        le_ = lane; asm volatile("" : "+v"(le_));
#pragma unroll
        for (int mh = 0; mh < 2; ++mh) {
            const int c32 = le_ & 31, h = le_ >> 5;
            const int mt = 2 * mt2 + wm2, jt = 2 * jt2 + (wn4 >> 1), wm = mh, wn = wn4 & 1;
            f32x16 (&acc)[2][2] = reinterpret_cast<f32x16 (&)[2][2]>(acc4[2 * mh]);
#pragma unroll
        for (int mi = 0; mi < 2; ++mi) {
            const int tok = mt * 128 + wm * 64 + mi * 32 + c32;
#pragma unroll
            for (int ni = 0; ni < 2; ++ni) {
                unsigned pv[8], gq[8], mq[8];
                load_row32(gates + (size_t)tok * 2048 + 1024 + jt * 128 + wn * 64 + ni * 32, gq, h);
                load_row32(MH + (size_t)tok * 1024 + jt * 128 + wn * 64 + ni * 32, mq, h);
#pragma unroll
                for (int q = 0; q < 4; ++q) {
                    u32x2 gv; gv.x = gq[2 * q]; gv.y = gq[2 * q + 1];
                    u32x2 pm; pm.x = mq[2 * q]; pm.y = mq[2 * q + 1];
                    const float m0 = __uint_as_float(pm.x << 16) + acc[mi][ni][4 * q] * __uint_as_float(gv.x << 16), m1 = __uint_as_float(pm.x & 0xffff0000u) + acc[mi][ni][4 * q + 1] * __uint_as_float(gv.x & 0xffff0000u);
                    const float m2 = __uint_as_float(pm.y << 16) + acc[mi][ni][4 * q + 2] * __uint_as_float(gv.y << 16), m3 = __uint_as_float(pm.y & 0xffff0000u) + acc[mi][ni][4 * q + 3] * __uint_as_float(gv.y & 0xffff0000u);
                    pv[2 * q] = pk(m0, m1); pv[2 * q + 1] = pk(m2, m3);
                }
                store_row32(MH + (size_t)tok * 1024 + jt * 128 + wn * 64 + ni * 32, pv, h);
            }
        }
        }
    }
}

template <int WHICH>
__device__ void phase_resgemm(const Params& p, LAS unsigned char* lds) {
    int tid_ = threadIdx.x; asm volatile("" : "+v"(tid_)); const int tid = tid_, lane = tid & 63, wid = tid >> 6, wm2 = wid >> 2, wn4 = wid & 3, c32 = lane & 31, h = lane >> 5;
    const int lrow = tid >> 2, lkc = (tid & 3) ^ ((tid >> 4) & 3);
    unsigned char* ws = p.ws;
    const int K = WHICH == 0 ? 1024 : 2816;
    const bf16_t* A = (const bf16_t*)(ws + (WHICH == 0 ? OFF_MH : OFF_ACT)); const bf16_t* B = (const bf16_t*)(ws + (WHICH == 0 ? OFF_WO : OFF_WD));
    f32x2* st = (f32x2*)((float*)(ws + OFF_STATS) + (size_t)10 * T);
    int mt2, jt2;
    for (int it = 0; xcd_tile256(it, 4, mt2, jt2); ++it) {
        unsigned ao[4], bo[4];
#pragma unroll
        for (int j = 0; j < 4; ++j) { const int r = lrow + 128 * (j & 1); ao[j] = (unsigned)((size_t)(mt2 * 256 + r) * K + lkc * 8); bo[j] = (unsigned)((size_t)(jt2 * 256 + r) * K + lkc * 8); }
        f32x16 acc4[4][2]; zero_acc4(acc4);
        gemm_core256<true>(tid, lds, A, ao, B, bo, K, acc4);
        int le_ = lane; asm volatile("" : "+v"(le_));
        {
            LAS float* Tw = (LAS float*)(lds + (tid >> 6) * 16384);
            const int c32 = le_ & 31, h = le_ >> 5, g4 = le_ >> 4, c16 = le_ & 15;
            const int mt = 2 * mt2 + wm2, jt = 2 * jt2 + (wn4 >> 1), wn = wn4 & 1;
#pragma unroll
            for (int mh = 0; mh < 2; ++mh) {
#pragma unroll
                for (int mi = 0; mi < 2; ++mi)
#pragma unroll
                    for (int ni = 0; ni < 2; ++ni)
#pragma unroll
                        for (int q = 0; q < 4; ++q) {
                            const int row = mi * 32 + c32, chunk = (ni * 8 + 2 * q + h) ^ (row & 15);
                            f32x4 v; v[0] = acc4[2 * mh + mi][ni][4 * q]; v[1] = acc4[2 * mh + mi][ni][4 * q + 1]; v[2] = acc4[2 * mh + mi][ni][4 * q + 2]; v[3] = acc4[2 * mh + mi][ni][4 * q + 3];
                            *(LAS f32x4*)(Tw + row * 64 + chunk * 4) = v;
                        }
                const int tok0 = mt * 128 + mh * 64, col = jt * 128 + wn * 64 + 4 * c16;
#pragma unroll
                for (int p_ = 0; p_ < 16; ++p_) {
                    const int row = 4 * p_ + g4, tok = tok0 + row;
                    LAS float* cp = Tw + row * 64 + ((c16 ^ (row & 15)) * 4);
                    const f32x4 v = *(const LAS f32x4*)cp;
                    f32x4 r;
                    if (WHICH == 0) r = *(const f32x4*)(xrow(p, tok) + col);
                    else { const u32x2 rb2 = *(const u32x2*)((const bf16_t*)(p.ws + OFF_MH) + (size_t)tok * 1024 + col);
                           r[0] = __uint_as_float(rb2.x << 16); r[1] = __uint_as_float(rb2.x & 0xffff0000u); r[2] = __uint_as_float(rb2.y << 16); r[3] = __uint_as_float(rb2.y & 0xffff0000u); }
                    f32x4 y; y[0] = ALPHA * r[0] + v[0]; y[1] = ALPHA * r[1] + v[1]; y[2] = ALPHA * r[2] + v[2]; y[3] = ALPHA * r[3] + v[3];
                    *(f32x4*)(p.out + (size_t)tok * 1024 + col) = y;
                    f32x2 sp; sp.x = (y[0] + y[1]) + (y[2] + y[3]); sp.y = (y[0] * y[0] + y[1] * y[1]) + (y[2] * y[2] + y[3] * y[3]);
                    *(LAS f32x2*)cp = sp;
                }
                {
                    const int row = le_; float s1 = 0.f, s2 = 0.f;
#pragma unroll
                    for (int j = 0; j < 16; ++j) { const f32x2 sp = *(const LAS f32x2*)(Tw + row * 64 + (((j + row) & 15) * 4)); s1 += sp.x; s2 += sp.y; }
                    f32x2 sv; sv.x = s1; sv.y = s2; st[(size_t)(tok0 + row) * 16 + jt * 2 + wn] = sv;
                }
            }
        }
        __syncthreads();
    }
}

template <int WHICH>
__device__ void phase_ln(const Params& p) {
    int tid_ = threadIdx.x; asm volatile("" : "+v"(tid_)); const int tid = tid_, lane = tid & 63, wid = tid >> 6;
    unsigned char* ws = p.ws;
    const f32x2* st = (const f32x2*)((const float*)(ws + OFF_STATS) + (size_t)10 * T);
    const float* gam = WHICH == 0 ? p.ln1_g : p.ln2_g; const float* bet = WHICH == 0 ? p.ln1_b : p.ln2_b;
    bf16_t* MH = (bf16_t*)(ws + OFF_MH);
    for (int row = blockIdx.x * 8 + wid; row < T; row += gridDim.x * 8) {
        const f32x2 pv = st[(size_t)row * 16 + (lane & 15)]; float s1 = pv.x, s2 = pv.y;
        s1 += __shfl_xor(s1, 8); s2 += __shfl_xor(s2, 8); s1 += __shfl_xor(s1, 4); s2 += __shfl_xor(s2, 4); s1 += __shfl_xor(s1, 2); s2 += __shfl_xor(s2, 2); s1 += __shfl_xor(s1, 1); s2 += __shfl_xor(s2, 1);
        const float mean = s1 * (1.f / 1024.f); const float var = fmaxf(s2 * (1.f / 1024.f) - mean * mean, 0.f); const float rstd = rsqrtf(var + 1e-5f);
        float* r = p.out + (size_t)row * 1024;
#pragma unroll
        for (int j = 0; j < 4; ++j) {
            const int col = j * 256 + lane * 4;
            const f32x4 v = *(const f32x4*)(r + col), g = *(const f32x4*)(gam + col), b = *(const f32x4*)(bet + col);
            f32x4 y; y[0] = (v[0] - mean) * rstd * g[0] + b[0]; y[1] = (v[1] - mean) * rstd * g[1] + b[1]; y[2] = (v[2] - mean) * rstd * g[2] + b[2]; y[3] = (v[3] - mean) * rstd * g[3] + b[3];
            if (WHICH == 1) *(f32x4*)(r + col) = y;
            if (WHICH == 0) { u32x2 w; w.x = pk(y[0], y[1]); w.y = pk(y[2], y[3]); *(u32x2*)(MH + (size_t)row * 1024 + col) = w; }
        }
    }
}

__device__ void phase_ffn_up(const Params& p, LAS unsigned char* lds) {
    int tid_ = threadIdx.x; asm volatile("" : "+v"(tid_)); const int tid = tid_, lane = tid & 63, wid = tid >> 6, wm2 = wid >> 2, wn4 = wid & 3, c32 = lane & 31, h = lane >> 5;
    const int lrow = tid >> 2, lkc = (tid & 3) ^ ((tid >> 4) & 3);
    unsigned char* ws = p.ws;
    const bf16_t* A = (const bf16_t*)(ws + OFF_MH); const bf16_t* B = (const bf16_t*)(ws + OFF_WGU); bf16_t* ACT = (bf16_t*)(ws + OFF_ACT);
    int mt2, jt2;
    for (int it = 0; xcd_tile256(it, 22, mt2, jt2); ++it) {
        unsigned ao[4], bo[4];
#pragma unroll
        for (int j = 0; j < 4; ++j) { const int r = lrow + 128 * (j & 1); ao[j] = (unsigned)((size_t)(mt2 * 256 + r) * 1024 + lkc * 8); bo[j] = (unsigned)((size_t)(jt2 * 256 + r) * 1024 + lkc * 8); }
        f32x16 acc4[4][2]; zero_acc4(acc4);
        gemm_core256<true>(tid, lds, A, ao, B, bo, 1024, acc4);
        int le_ = lane; asm volatile("" : "+v"(le_));
#pragma unroll
        for (int mh = 0; mh < 2; ++mh) {
            const int c32 = le_ & 31, h = le_ >> 5;
            const int mt = 2 * mt2 + wm2, jt = 2 * jt2 + (wn4 >> 1), wm = mh, wn = wn4 & 1;
            f32x16 (&acc)[2][2] = reinterpret_cast<f32x16 (&)[2][2]>(acc4[2 * mh]);
#pragma unroll
        for (int mi = 0; mi < 2; ++mi) {
            const int tok = mt * 128 + wm * 64 + mi * 32 + c32;
            bf16_t* arow = ACT + (size_t)tok * 2816 + (jt * 2 + wn) * 32;
            unsigned pv[8];
#pragma unroll
            for (int q = 0; q < 4; ++q) {
                float v[4];
#pragma unroll
                for (int e = 0; e < 4; ++e) { const float g = acc[mi][0][4 * q + e], u = acc[mi][1][4 * q + e]; v[e] = g * u * __builtin_amdgcn_rcpf(1.f + __expf(-g)); }
                pv[2 * q] = pk(v[0], v[1]); pv[2 * q + 1] = pk(v[2], v[3]);
            }
            store_row32(arow, pv, h);
        }
        }
    }
}

__global__ void __launch_bounds__(512, 2) mega(Params p) {
    __shared__ __attribute__((aligned(16))) unsigned char smem[LDS_BYTES];
    LAS unsigned char* lds = (LAS unsigned char*)smem;
    cg::grid_group grid = cg::this_grid();
    const int lo = p.ph_lo, hi = p.ph_hi;
#if !defined(PHASE_MASK) || ((PHASE_MASK >> 0) & 1)
    if (lo <= 0 && 0 < hi) { phase_prep(p, lds);
#if defined(DUP_PHASE) && DUP_PHASE == 0
        grid.sync(); phase_prep(p, lds);
#endif
        if (0 + 1 < hi) grid.sync(); }
#endif
#if !defined(PHASE_MASK) || ((PHASE_MASK >> 1) & 1)
    if (lo <= 1 && 1 < hi) { phase_inproj(p, lds);
#if defined(DUP_PHASE) && DUP_PHASE == 1
        grid.sync(); phase_inproj(p, lds);
#endif
        if (1 + 1 < hi) grid.sync(); }
#endif
#ifdef EXP_CANARY
    { u32x4* q = (u32x4*)(p.ws + OFF_Q); const size_t n = (size_t)192 * MiB / 16; u32x4 v; v.x = v.y = v.z = v.w = 0x7fc07fc0u;
      int t_ = threadIdx.x; asm volatile("" : "+v"(t_));
      for (size_t i = (size_t)blockIdx.x * 256 + t_; i < n; i += (size_t)gridDim.x * 256) q[i] = v; grid.sync(); }
#endif
#if !defined(PHASE_MASK) || ((PHASE_MASK >> 2) & 1)
    if (lo <= 2 && 2 < hi) { phase_up(p, lds);
#if defined(DUP_PHASE) && DUP_PHASE == 2
        grid.sync(); phase_up(p, lds);
#endif
        if (2 + 1 < hi) grid.sync(); }
#endif
#ifdef EXP_CANARY
    { u32x4* q = (u32x4*)(p.ws + OFF_O); const size_t n = (size_t)48 * MiB / 16; u32x4 v; v.x = v.y = v.z = v.w = 0x7fc07fc0u;
      int t_ = threadIdx.x; asm volatile("" : "+v"(t_));
      for (size_t i = (size_t)blockIdx.x * 256 + t_; i < n; i += (size_t)gridDim.x * 256) q[i] = v; grid.sync(); }
#endif
#if !defined(PHASE_MASK) || ((PHASE_MASK >> 3) & 1)
    if (lo <= 3 && 3 < hi) { phase_attn(p, lds);
#if defined(DUP_PHASE) && DUP_PHASE == 3
        grid.sync(); phase_attn(p, lds);
#endif
        if (3 + 1 < hi) grid.sync(); }
#endif
#if !defined(PHASE_MASK) || ((PHASE_MASK >> 4) & 1)
    if (lo <= 4 && 4 < hi) { phase_merge(p, lds);
#if defined(DUP_PHASE) && DUP_PHASE == 4
        grid.sync(); phase_merge(p, lds);
#endif
        if (4 + 1 < hi) grid.sync(); }
#endif
#if !defined(PHASE_MASK) || ((PHASE_MASK >> 5) & 1)
    if (lo <= 5 && 5 < hi) { phase_resgemm<0>(p, lds);
#if defined(DUP_PHASE) && DUP_PHASE == 5
        grid.sync(); phase_resgemm<0>(p, lds);
#endif
        if (5 + 1 < hi) grid.sync(); }
#endif
#if !defined(PHASE_MASK) || ((PHASE_MASK >> 6) & 1)
    if (lo <= 6 && 6 < hi) { phase_ln<0>(p);
#if defined(DUP_PHASE) && DUP_PHASE == 6
        grid.sync(); phase_ln<0>(p);
#endif
        if (6 + 1 < hi) grid.sync(); }
#endif
#if !defined(PHASE_MASK) || ((PHASE_MASK >> 7) & 1)
    if (lo <= 7 && 7 < hi) { phase_ffn_up(p, lds);
#if defined(DUP_PHASE) && DUP_PHASE == 7
        grid.sync(); phase_ffn_up(p, lds);
#endif
        if (7 + 1 < hi) grid.sync(); }
#endif
#if !defined(PHASE_MASK) || ((PHASE_MASK >> 8) & 1)
    if (lo <= 8 && 8 < hi) { phase_resgemm<1>(p, lds);
#if defined(DUP_PHASE) && DUP_PHASE == 8
        grid.sync(); phase_resgemm<1>(p, lds);
#endif
        if (8 + 1 < hi) grid.sync(); }
#endif
#if !defined(PHASE_MASK) || ((PHASE_MASK >> 9) & 1)
    if (lo <= 9 && 9 < hi) { phase_ln<1>(p);
#if defined(DUP_PHASE) && DUP_PHASE == 9
        grid.sync(); phase_ln<1>(p);
#endif
        if (9 + 1 < hi) grid.sync(); }
#endif
}

extern "C" void kernel_launch(void* const* d_in, const int* in_sizes, int n_in, void* d_out, int out_size, void* d_ws, size_t ws_size, hipStream_t stream) {
    static int grid_blocks = 0;
    if (!grid_blocks) {
        int dev = 0, cus = 0, per_cu = 0;
        hipGetDevice(&dev);
        hipDeviceGetAttribute(&cus, hipDeviceAttributeMultiprocessorCount, dev);
        hipOccupancyMaxActiveBlocksPerMultiprocessor(&per_cu, mega, 512, 0);
        if (per_cu < 1) per_cu = 1;
        if (per_cu > 1) per_cu = 1;
        grid_blocks = cus * per_cu;
        if (ws_size < WS_END) { fprintf(stderr, "kernel_launch: workspace too small: %zu < %zu\n", ws_size, (size_t)WS_END); grid_blocks = -1; }
    }
    if (grid_blocks < 0) return;
    Params p{};
    p.x_prompt = (const float*)d_in[0]; p.x_sample = (const float*)d_in[1]; p.w_in = (const float*)d_in[2]; p.w_fourier = (const float*)d_in[3];
    p.g_q = (const float*)d_in[4]; p.w_uq = (const float*)d_in[5]; p.g_kv = (const float*)d_in[6]; p.w_ukv = (const float*)d_in[7];
    p.w_attn = (const float*)d_in[8]; p.w_o = (const float*)d_in[9]; p.ln1_g = (const float*)d_in[10]; p.ln1_b = (const float*)d_in[11];
    p.w_gate = (const float*)d_in[12]; p.w_up = (const float*)d_in[13]; p.w_down = (const float*)d_in[14]; p.ln2_g = (const float*)d_in[15]; p.ln2_b = (const float*)d_in[16];
    p.out = (float*)d_out; p.ws = (unsigned char*)d_ws;
#if COOP
    p.ph_lo = 0; p.ph_hi = NPHASE;
    void* args[] = {&p};
    hipError_t e = hipLaunchCooperativeKernel((void*)mega, dim3(grid_blocks), dim3(512), args, 0, stream);
    if (e != hipSuccess) fprintf(stderr, "cooperative launch failed: %s (grid %d)\n", hipGetErrorString(e), grid_blocks);
#else
    for (int ph = 0; ph < NPHASE; ++ph) {
        p.ph_lo = ph; p.ph_hi = ph + 1;
        hipLaunchKernelGGL(mega, dim3(grid_blocks), dim3(512), 0, stream, p);
    }
#endif
}
```

```cpp
#include <hip/hip_runtime.h>
#include <hip/hip_cooperative_groups.h>
#include <stdint.h>
#include <stdio.h>
namespace cg = cooperative_groups;

#ifndef COOP
#define COOP 1
#endif

#define LAS __attribute__((address_space(3)))
typedef unsigned short bf16_t;
typedef short bf16x8 __attribute__((ext_vector_type(8)));
typedef float f32x16 __attribute__((ext_vector_type(16)));
typedef float f32x4 __attribute__((ext_vector_type(4)));
typedef float f32x2 __attribute__((ext_vector_type(2)));
typedef unsigned u32x4 __attribute__((ext_vector_type(4)));
typedef unsigned u32x2 __attribute__((ext_vector_type(2)));

constexpr int T = 49152, TP = 16384;
constexpr size_t MiB = (size_t)1 << 20;
constexpr size_t OFF_W1P = 0, OFF_W1S = 32 * MiB, OFF_FB = 0, OFF_O = 48 * MiB, OFF_XB = 96 * MiB, OFF_Q = 96 * MiB, OFF_K = 168 * MiB,
                 OFF_VT = 240 * MiB, OFF_A2P = 288 * MiB, OFF_A2S = 320 * MiB, OFF_MH = 96 * MiB, OFF_ACT = 192 * MiB, OFF_CQ = 384 * MiB,
                 OFF_CKV = 420 * MiB, OFF_KPE = 444 * MiB, OFF_WT = 456 * MiB;
constexpr size_t OFF_WIN = OFF_WT;
constexpr size_t OFF_WF = OFF_WIN + (size_t)3840 * 1024 * 2;
constexpr size_t OFF_WAT = OFF_WF + (size_t)1024 * 512 * 2;
constexpr size_t OFF_WO = OFF_WAT + (size_t)1024 * 512 * 2;
constexpr size_t OFF_WGU = OFF_WO + (size_t)1024 * 1024 * 2;
constexpr size_t OFF_WD = OFF_WGU + (size_t)5632 * 1024 * 2;
constexpr size_t OFF_WUQ = OFF_WD + (size_t)1024 * 2816 * 2;
constexpr size_t OFF_WUKV = OFF_WUQ + (size_t)768 * 384 * 2;
constexpr size_t OFF_FA128 = OFF_WUKV + (size_t)1024 * 256 * 2;
constexpr size_t OFF_FA64 = OFF_FA128 + (size_t)256 * 256 * 2;
constexpr size_t OFF_FB128 = OFF_FA64 + (size_t)128 * 128 * 2;
constexpr size_t OFF_FB64 = OFF_FB128 + (size_t)128 * 256 * 2;
constexpr size_t OFF_ROPE = OFF_FB64 + (size_t)128 * 128 * 2;
constexpr size_t OFF_STATS = OFF_ROPE + (size_t)16384 * 16 * 8;
constexpr size_t WS_END = OFF_STATS + ((size_t)42 * T) * 4;

constexpr int GSTR = 144;
constexpr int KSTR = 208, VSTR = 136;
constexpr int LDS_BYTES = 131072;
constexpr float ALPHA = 1.189207115002721f;
constexpr float QSCALE = 0.10206207261596575f * 1.4426950408889634f;
constexpr int NPHASE = 10;

struct Params {
    const float *x_prompt, *x_sample, *w_in, *w_fourier, *g_q, *w_uq, *g_kv, *w_ukv, *w_attn, *w_o, *ln1_g, *ln1_b, *w_gate, *w_up, *w_down, *ln2_g, *ln2_b;
    float* out; unsigned char* ws; int ph_lo, ph_hi;
};

__device__ const double INVFREQ_D[16] = {1.0, 0.5623413251903491, 0.31622776601683794, 0.1778279410038923, 0.1, 0.05623413251903491, 0.03162277660168379, 0.01778279410038923,
                                         0.01, 0.005623413251903491, 0.0031622776601683794, 0.001778279410038923, 0.001, 0.0005623413251903491, 0.00031622776601683794, 0.0001778279410038923};

typedef __bf16 bf16x2_t __attribute__((ext_vector_type(2)));
__device__ __forceinline__ unsigned pk(float lo, float hi) { f32x2 v; v.x = lo; v.y = hi; const bf16x2_t b = __builtin_convertvector(v, bf16x2_t); return __builtin_bit_cast(unsigned, b); }
__device__ __forceinline__ void store_row32(bf16_t* base, const unsigned (&pv)[8], int h) {
#pragma unroll
    for (int k = 0; k < 4; k += 2) {
        unsigned ax = pv[2 * k], ay = pv[2 * k + 1], bx = pv[2 * k + 2], by = pv[2 * k + 3];
        { auto r_ = __builtin_amdgcn_permlane32_swap(ax, bx, false, false); ax = r_[0]; bx = r_[1]; }
        { auto r_ = __builtin_amdgcn_permlane32_swap(ay, by, false, false); ay = r_[0]; by = r_[1]; }
        u32x4 w; w.x = ax; w.y = ay; w.z = bx; w.w = by;
        *(u32x4*)(base + 8 * k + 8 * h) = w;
    }
}
__device__ __forceinline__ void load_row32(const bf16_t* base, unsigned (&pv)[8], int h) {
#pragma unroll
    for (int k = 0; k < 4; k += 2) {
        const u32x4 w = *(const u32x4*)(base + 8 * k + 8 * h);
        unsigned ax = w.x, ay = w.y, bx = w.z, by = w.w;
        { auto r_ = __builtin_amdgcn_permlane32_swap(ax, bx, false, false); ax = r_[0]; bx = r_[1]; }
        { auto r_ = __builtin_amdgcn_permlane32_swap(ay, by, false, false); ay = r_[0]; by = r_[1]; }
        pv[2 * k] = ax; pv[2 * k + 1] = ay; pv[2 * k + 2] = bx; pv[2 * k + 3] = by;
    }
}
__device__ __forceinline__ float cos_rev(float r) { return __builtin_amdgcn_cosf(r); }
__device__ __forceinline__ float sin_rev(float r) { return __builtin_amdgcn_sinf(r); }
__device__ __forceinline__ float bf2f(unsigned short v) { return __uint_as_float((unsigned)v << 16); }
__device__ __forceinline__ f32x16 mfma32(bf16x8 a, bf16x8 b, f32x16 c) { return __builtin_amdgcn_mfma_f32_32x32x16_bf16(a, b, c, 0, 0, 0); }
__device__ __forceinline__ void tok_info(int t, int& seq_start, int& S, int& pos) {
    if (t < TP) { seq_start = 0; S = 16384; pos = t; } else { const int u = t - TP; seq_start = TP + (u & ~4095); S = 4096; pos = u & 4095; }
}
__device__ __forceinline__ const float* xrow(const Params& p, int tok) { return tok < TP ? p.x_prompt + (size_t)tok * 1024 : p.x_sample + (size_t)(tok - TP) * 1024; }
__device__ __forceinline__ void zero_acc(f32x16 (&acc)[2][2]) {
#pragma unroll
    for (int a = 0; a < 2; ++a)
#pragma unroll
        for (int b = 0; b < 2; ++b)
#pragma unroll
            for (int e = 0; e < 16; ++e) acc[a][b][e] = 0.f;
}

template <bool SWAP>
__device__ __forceinline__ void gemm_core(const int tid, LAS unsigned char* lds, const bf16_t* __restrict__ Ab, const unsigned (&ao)[4], const bf16_t* __restrict__ Bb, const unsigned (&bo)[4], int K, f32x16 (&acc)[2][2]) {
    const int lane = tid & 63, wid = tid >> 6, wm = wid >> 1, wn = wid & 1;
    const int w = __builtin_amdgcn_readfirstlane(wid);
    const int c32 = lane & 31, t3 = (lane >> 5) ^ ((c32 >> 1) & 7);
    const int aoff = (wm * 64 + c32) * 128 + t3 * 16;
    const int boff = 16384 + (wn * 64 + c32) * 128 + t3 * 16;
    const int nk = K >> 6;
#define GEMM_ISSUE(kt_, buf_) do { _Pragma("unroll") for (int j_ = 0; j_ < 4; ++j_) { \
        __builtin_amdgcn_global_load_lds((const unsigned*)(Ab + (ao[j_] + (unsigned)(kt_) * 64u)), (LAS unsigned*)(lds + (buf_) * 32768 + (w + 4 * j_) * 1024), 16, 0, 0); \
        __builtin_amdgcn_global_load_lds((const unsigned*)(Bb + (bo[j_] + (unsigned)(kt_) * 64u)), (LAS unsigned*)(lds + (buf_) * 32768 + 16384 + (w + 4 * j_) * 1024), 16, 0, 0); } } while (0)
    GEMM_ISSUE(0, 0);
#pragma unroll 1
    for (int kt = 0; kt < nk; ++kt) {
        asm volatile("s_waitcnt vmcnt(0)" ::: "memory");
        __syncthreads();
        if (kt + 1 < nk) GEMM_ISSUE(kt + 1, (kt + 1) & 1);
        LAS unsigned char* sb = lds + (kt & 1) * 32768;
        bf16x8 fa[2][2], fb[2][2];
        fa[0][0] = *(const LAS bf16x8*)(sb + aoff); fa[0][1] = *(const LAS bf16x8*)(sb + aoff + 32 * 128);
        fb[0][0] = *(const LAS bf16x8*)(sb + boff); fb[0][1] = *(const LAS bf16x8*)(sb + boff + 32 * 128);
#pragma unroll
        for (int kk = 0; kk < 4; ++kk) {
            const int c = kk & 1, n = c ^ 1;
            if (kk < 3) {
                fa[n][0] = *(const LAS bf16x8*)(sb + (aoff ^ ((kk + 1) * 32))); fa[n][1] = *(const LAS bf16x8*)(sb + ((aoff + 32 * 128) ^ ((kk + 1) * 32)));
                fb[n][0] = *(const LAS bf16x8*)(sb + (boff ^ ((kk + 1) * 32))); fb[n][1] = *(const LAS bf16x8*)(sb + ((boff + 32 * 128) ^ ((kk + 1) * 32)));
            }
            if (SWAP) { acc[0][0] = mfma32(fb[c][0], fa[c][0], acc[0][0]); acc[0][1] = mfma32(fb[c][1], fa[c][0], acc[0][1]); acc[1][0] = mfma32(fb[c][0], fa[c][1], acc[1][0]); acc[1][1] = mfma32(fb[c][1], fa[c][1], acc[1][1]); }
            else      { acc[0][0] = mfma32(fa[c][0], fb[c][0], acc[0][0]); acc[0][1] = mfma32(fa[c][0], fb[c][1], acc[0][1]); acc[1][0] = mfma32(fa[c][1], fb[c][0], acc[1][0]); acc[1][1] = mfma32(fa[c][1], fb[c][1], acc[1][1]); }
        }
    }
#undef GEMM_ISSUE
    __syncthreads();
}

__device__ __forceinline__ bool xcd_tile(int it, int NT, int& mt, int& jt) {
    const int G = gridDim.x, b = blockIdx.x;
    if (G & 7) { const int tile = b + it * G; if (tile >= 384 * NT) return false; mt = tile / NT; jt = tile - mt * NT; return true; }
    const int xcd = b & 7, local = b >> 3, nloc = G >> 3;
    const int o = local + it * nloc; if (o >= 48 * NT) return false;
    const int pw = 8 * NT, pnl = o / pw, idx = o - pnl * pw;
    jt = idx >> 3; mt = 48 * xcd + 8 * pnl + (idx & 7); return true;
}

__device__ __forceinline__ void zero_acc4(f32x16 (&acc)[4][2]) {
#pragma unroll
    for (int a = 0; a < 4; ++a)
#pragma unroll
        for (int b = 0; b < 2; ++b)
#pragma unroll
            for (int e = 0; e < 16; ++e) acc[a][b][e] = 0.f;
}
template <bool SWAP>
__device__ __forceinline__ void gemm_core256(const int tid, LAS unsigned char* lds, const bf16_t* __restrict__ Ab, const unsigned (&ao)[4], const bf16_t* __restrict__ Bb, const unsigned (&bo)[4], int K, f32x16 (&acc)[4][2]) {
    const int lane = tid & 63, wid = tid >> 6, wm = wid >> 2, wn = wid & 3;
    const int w = __builtin_amdgcn_readfirstlane(wid);
    const int grp = w >> 2;
    const int c32 = lane & 31, t2 = (lane >> 5) ^ ((c32 >> 2) & 3);
    const int aoff = (wm * 128 + c32) * 64 + t2 * 16;
    const int boff = 16384 + (wn * 64 + c32) * 64 + t2 * 16;
    const int nk = K >> 5;
#define G256_ISSUE1(j_, kt_, buf_) do { \
        __builtin_amdgcn_global_load_lds((const unsigned*)(Ab + (ao[j_] + (unsigned)(kt_) * 32u)), (LAS unsigned*)(lds + (buf_) * 32768 + (w + 8 * (j_)) * 1024), 16, 0, 0); \
        __builtin_amdgcn_global_load_lds((const unsigned*)(Bb + (bo[j_] + (unsigned)(kt_) * 32u)), (LAS unsigned*)(lds + (buf_) * 32768 + 16384 + (w + 8 * (j_)) * 1024), 16, 0, 0); } while (0)
#define G256_BAR do { asm volatile("" ::: "memory"); __builtin_amdgcn_s_barrier(); asm volatile("" ::: "memory"); } while (0)
#define G256_SB __builtin_amdgcn_sched_barrier(0)
#define G256_LDA do { _Pragma("unroll") for (int i_ = 0; i_ < 4; ++i_) _Pragma("unroll") for (int k_ = 0; k_ < 2; ++k_) \
        fa[i_][k_] = *(const LAS bf16x8*)(sb + ((aoff + i_ * 32 * 64) ^ (k_ * 32))); } while (0)
#define G256_LDB do { _Pragma("unroll") for (int n_ = 0; n_ < 2; ++n_) _Pragma("unroll") for (int k_ = 0; k_ < 2; ++k_) \
        fb[n_][k_] = *(const LAS bf16x8*)(sb + ((boff + n_ * 32 * 64) ^ (k_ * 32))); } while (0)
#define G256_MMA do { _Pragma("unroll") for (int k_ = 0; k_ < 2; ++k_) _Pragma("unroll") for (int i_ = 0; i_ < 4; ++i_) _Pragma("unroll") for (int n_ = 0; n_ < 2; ++n_) { \
        if (SWAP) acc[i_][n_] = mfma32(fb[n_][k_], fa[i_][k_], acc[i_][n_]); else acc[i_][n_] = mfma32(fa[i_][k_], fb[n_][k_], acc[i_][n_]); } \
        } while (0)
#define G256_ENDL do { asm volatile("s_waitcnt lgkmcnt(0)" ::: "memory"); G256_SB; G256_BAR; G256_SB; } while (0)
    G256_ISSUE1(0, 0, 0); G256_ISSUE1(1, 0, 0);
    if (nk > 1) { G256_ISSUE1(0, 1, 1); G256_ISSUE1(1, 1, 1); asm volatile("s_waitcnt vmcnt(4)" ::: "memory"); }
    else asm volatile("s_waitcnt vmcnt(0)" ::: "memory");
    G256_BAR;
    if (grp == 1) G256_BAR;
#pragma unroll 1
    for (int kt = 0; kt < nk; ++kt) {
        LAS unsigned char* sb = lds + (kt & 3) * 32768; const int nb = (kt + 2) & 3; const bool more2 = kt + 2 < nk;
        bf16x8 fa[4][2], fb[2][2];
        G256_SB; G256_LDA; G256_LDB;
        if (more2) { G256_ISSUE1(0, kt + 2, nb); G256_ISSUE1(1, kt + 2, nb); asm volatile("s_waitcnt vmcnt(4)" ::: "memory"); } else asm volatile("s_waitcnt vmcnt(0)" ::: "memory");
        G256_ENDL;
        G256_MMA; G256_SB; G256_BAR; G256_SB;
    }
    if (grp == 0) G256_BAR;
#undef G256_ENDL
#undef G256_MMA
#undef G256_LDB
#undef G256_LDA
#undef G256_SB
#undef G256_BAR
#undef G256_ISSUE1
}

__device__ __forceinline__ bool xcd_tile256(int it, int NT, int& mt, int& jt) {
    const int G = gridDim.x, b = blockIdx.x;
    if (G & 7) { const int tile = b + it * G; if (tile >= 192 * NT) return false; mt = tile / NT; jt = tile - mt * NT; return true; }
    const int xcd = b & 7, local = b >> 3, nloc = G >> 3;
    const int o = local + it * nloc; if (o >= 24 * NT) return false;
    const int pw = 4 * NT, pnl = o / pw, idx = o - pnl * pw;
    jt = idx >> 2; mt = 24 * xcd + 4 * pnl + (idx & 3); return true;
}

template <class F>
__device__ __forceinline__ void transpose_job(const int tid, const int half, LAS unsigned char* lds, bf16_t* dst, int K, int N, F f) {
    LAS float* tl = (LAS float*)lds;
    const int ntn = N >> 6, ntk = K >> 6, nt = ntn * ntk;
    for (int t0 = blockIdx.x * 2; t0 < nt; t0 += gridDim.x * 2) {
        const int tile = (t0 + half < nt) ? t0 + half : nt - 1;
        const int n0 = (tile / ntk) << 6, k0 = (tile % ntk) << 6;
        __syncthreads();
#pragma unroll 4
        for (int r = 0; r < 16; ++r) { const int kl = (tid >> 6) + 4 * r, nl = tid & 63; tl[kl * 65 + nl] = f(k0 + kl, n0 + nl); }
        __syncthreads();
        const int nl = tid >> 2, kq = tid & 3;
        u32x4 w0, w1;
        w0.x = pk(tl[(kq * 16 + 0) * 65 + nl], tl[(kq * 16 + 1) * 65 + nl]); w0.y = pk(tl[(kq * 16 + 2) * 65 + nl], tl[(kq * 16 + 3) * 65 + nl]);
        w0.z = pk(tl[(kq * 16 + 4) * 65 + nl], tl[(kq * 16 + 5) * 65 + nl]); w0.w = pk(tl[(kq * 16 + 6) * 65 + nl], tl[(kq * 16 + 7) * 65 + nl]);
        w1.x = pk(tl[(kq * 16 + 8) * 65 + nl], tl[(kq * 16 + 9) * 65 + nl]); w1.y = pk(tl[(kq * 16 + 10) * 65 + nl], tl[(kq * 16 + 11) * 65 + nl]);
        w1.z = pk(tl[(kq * 16 + 12) * 65 + nl], tl[(kq * 16 + 13) * 65 + nl]); w1.w = pk(tl[(kq * 16 + 14) * 65 + nl], tl[(kq * 16 + 15) * 65 + nl]);
        bf16_t* d = dst + (size_t)(n0 + nl) * K + k0 + kq * 16;
        *(u32x4*)d = w0; *(u32x4*)(d + 8) = w1;
    }
    __syncthreads();
}

__device__ void phase_prep(const Params& p, LAS unsigned char* lds_) {
    int tid_ = threadIdx.x; asm volatile("" : "+v"(tid_)); const int half = tid_ >> 8, tid = tid_ & 255, bid = blockIdx.x * 2 + half, gsz = gridDim.x * 2;
    LAS unsigned char* lds = lds_ + half * 65536;
    const size_t gtid = (size_t)bid * 256 + tid, gth = (size_t)gsz * 256;
    unsigned char* ws = p.ws;
#ifdef EXP_CANARY
    { u32x4 v; v.x = v.y = v.z = v.w = 0x7fc07fc0u;
      u32x4* a = (u32x4*)(ws + OFF_CQ); for (size_t i = gtid; i < (size_t)63 * MiB / 16; i += gth) a[i] = v;
      u32x4* b = (u32x4*)(ws + OFF_STATS); for (size_t i = gtid; i < (size_t)42 * T * 4 / 16; i += gth) b[i] = v;
      u32x4* c = (u32x4*)p.out; for (size_t i = gtid; i < (size_t)192 * MiB / 16; i += gth) c[i] = v; }
#endif
    { bf16_t* xb = (bf16_t*)(ws + OFF_XB);
      const size_t NX = (size_t)T * 1024 / 8;
      for (size_t i0 = gtid; i0 < NX; i0 += 4 * gth) {
          if (i0 + 3 * gth < NX) {
              f32x4 a4[4], b4[4];
#pragma unroll
              for (int u = 0; u < 4; ++u) { const size_t e = (i0 + u * gth) * 8; const float* src = (e < (size_t)TP * 1024) ? p.x_prompt + e : p.x_sample + (e - (size_t)TP * 1024);
                  a4[u] = *(const f32x4*)src; b4[u] = *(const f32x4*)(src + 4); }
#pragma unroll
              for (int u = 0; u < 4; ++u) { const size_t e = (i0 + u * gth) * 8;
                  u32x4 w; w.x = pk(a4[u][0], a4[u][1]); w.y = pk(a4[u][2], a4[u][3]); w.z = pk(b4[u][0], b4[u][1]); w.w = pk(b4[u][2], b4[u][3]);
                  *(u32x4*)(xb + e) = w; }
          } else {
              for (size_t i = i0; i < NX; i += gth) {
                  const size_t e = i * 8; const float* src = (e < (size_t)TP * 1024) ? p.x_prompt + e : p.x_sample + (e - (size_t)TP * 1024);
                  const f32x4 a = *(const f32x4*)src, b = *(const f32x4*)(src + 4);
                  u32x4 w; w.x = pk(a[0], a[1]); w.y = pk(a[2], a[3]); w.z = pk(b[0], b[1]); w.w = pk(b[2], b[3]);
                  *(u32x4*)(xb + e) = w; }
          }
      } }
    { f32x2* rope = (f32x2*)(ws + OFF_ROPE);
      for (size_t i = gtid; i < (size_t)16384 * 16; i += gth) {
          const int s = (int)(i >> 4), j = (int)(i & 15); const float invf = (float)INVFREQ_D[j]; const float ang = (float)s * invf;
          double rev = (double)ang * 0.15915494309189535; rev -= floor(rev); const float r = (float)rev;
          f32x2 v; v.x = cos_rev(r); v.y = sin_rev(r); rope[i] = v; } }
    { bf16_t* fa = (bf16_t*)(ws + OFF_FA128);
      for (size_t i = gtid; i < (size_t)256 * 256; i += gth) { const int n = (int)(i >> 8), k = (int)(i & 255); const int ro = (n >> 5) & 1, k1 = (n >> 6) * 32 + (n & 31), n1 = k >> 1, ri = k & 1;
          const float r = (float)((k1 * n1) & 127) * (1.f / 128.f); const float c = cos_rev(r), s = sin_rev(r); const float v = ro == 0 ? (ri == 0 ? c : s) : (ri == 0 ? -s : c);
          fa[i] = (bf16_t)(pk(v, 0.f) & 0xffff); }
      bf16_t* fa6 = (bf16_t*)(ws + OFF_FA64);
      for (size_t i = gtid; i < (size_t)128 * 128; i += gth) { const int n = (int)(i >> 7), k = (int)(i & 127); const int ro = (n >> 5) & 1, k1 = (n >> 6) * 32 + (n & 31), n1 = k >> 1, ri = k & 1;
          const float r = (float)((k1 * n1) & 63) * (1.f / 64.f); const float c = cos_rev(r), s = sin_rev(r); const float v = ro == 0 ? (ri == 0 ? c : s) : (ri == 0 ? -s : c);
          fa6[i] = (bf16_t)(pk(v, 0.f) & 0xffff); }
      bf16_t* fb = (bf16_t*)(ws + OFF_FB128);
      for (size_t i = gtid; i < (size_t)128 * 256; i += gth) { const int k2 = (int)(i >> 8), k = (int)(i & 255); const int n2 = k >> 1, ri = k & 1;
          const float r = (float)((k2 * n2) & 127) * (1.f / 128.f); const float v = ri == 0 ? cos_rev(r) : sin_rev(r); fb[i] = (bf16_t)(pk(v, 0.f) & 0xffff); }
      bf16_t* fb6 = (bf16_t*)(ws + OFF_FB64);
      for (size_t i = gtid; i < (size_t)128 * 128; i += gth) { const int k2 = (int)(i >> 7), k = (int)(i & 127); const int n2 = k >> 1, ri = k & 1;
          const float r = (float)((k2 * n2) & 63) * (1.f / 64.f); float v = ri == 0 ? cos_rev(r) : sin_rev(r); if (k2 >= 64) v = 0.f; fb6[i] = (bf16_t)(pk(v, 0.f) & 0xffff); } }
    { LAS float* cs = (LAS float*)lds; LAS float* sn = cs + 128;
      __syncthreads();
      if (tid < 128) { const float r = (float)tid * (1.f / 128.f); cs[tid] = cos_rev(r); sn[tid] = sin_rev(r); }
      __syncthreads();
      bf16_t* wt = (bf16_t*)(ws + OFF_WIN);
      for (int it = bid; it < 1024 * 4; it += gsz) {
          const int k = it >> 2, n = (it & 3) * 256 + tid;
          const int jt = n >> 7, cl = n & 127, g = jt >> 1, hf = jt & 1, sub = cl >> 5, cc = cl & 31, wn = sub >> 1, reim = sub & 1, cp = hf * 64 + wn * 32 + cc;
          const float* wr = p.w_in + (size_t)k * 3232 + g * 128;
          float acc = 0.f;
          for (int c = 0; c < 128; c += 4) {
              const f32x4 w4 = *(const f32x4*)(wr + c);
#pragma unroll
              for (int e = 0; e < 4; ++e) { const int idx = ((c + e) * cp) & 127; const float tw = reim ? -sn[idx] : cs[idx]; acc += w4[e] * tw; }
          }
          wt[(size_t)n * 1024 + k] = (bf16_t)(pk(acc, 0.f) & 0xffff);
      }
      __syncthreads(); }
    { const float* w_in = p.w_in;
      transpose_job(tid, half, lds, (bf16_t*)(ws + OFF_WIN) + (size_t)1024 * 1024, 1024, 2816, [=](int k, int n) -> float {
          int src; if (n < 384) src = 512 + n; else if (n < 640) src = 896 + (n - 384); else if (n < 768) src = (n - 640 < 32) ? 1152 + (n - 640) : -1; else src = 1184 + (n - 768);
          return src >= 0 ? w_in[(size_t)k * 3232 + src] : 0.f; }); }
    { const float* w = p.w_fourier; transpose_job(tid, half, lds, (bf16_t*)(ws + OFF_WF), 512, 1024, [=](int k, int n) -> float { return w[(size_t)k * 1024 + n]; }); }
    { const float* w = p.w_attn; transpose_job(tid, half, lds, (bf16_t*)(ws + OFF_WAT), 512, 1024, [=](int k, int n) -> float { return w[(size_t)k * 1024 + n]; }); }
    { const float* w = p.w_o; transpose_job(tid, half, lds, (bf16_t*)(ws + OFF_WO), 1024, 1024, [=](int k, int n) -> float { return w[(size_t)k * 1024 + n]; }); }
    { const float* wg = p.w_gate; const float* wu = p.w_up;
      transpose_job(tid, half, lds, (bf16_t*)(ws + OFF_WGU), 1024, 5632, [=](int k, int n) -> float { const int grp = n >> 6, r = n & 63; return r < 32 ? wg[(size_t)k * 2816 + grp * 32 + r] : wu[(size_t)k * 2816 + grp * 32 + r - 32]; }); }
    { const float* w = p.w_down; transpose_job(tid, half, lds, (bf16_t*)(ws + OFF_WD), 2816, 1024, [=](int k, int n) -> float { return w[(size_t)k * 1024 + n]; }); }
    { const float* w = p.w_uq; const float* g = p.g_q; transpose_job(tid, half, lds, (bf16_t*)(ws + OFF_WUQ), 384, 768, [=](int k, int n) -> float { return w[(size_t)k * 768 + n] * g[k]; }); }
    { const float* w = p.w_ukv; const float* g = p.g_kv;
      transpose_job(tid, half, lds, (bf16_t*)(ws + OFF_WUKV), 256, 1024, [=](int k, int n) -> float { const int col = n < 512 ? (n >> 6) * 128 + (n & 63) : ((n - 512) >> 6) * 128 + 64 + (n & 63); return w[(size_t)k * 1024 + col] * g[k]; }); }
}

__device__ __forceinline__ int p1_token(int mt, int i) {
    if (mt < 128) return 128 * i + mt;
    const int idx = mt - 128, b = idx >> 5, pr = idx & 31;
    return TP + b * 4096 + 64 * (i & 63) + 2 * pr + (i >> 6);
}

__device__ void phase_inproj(const Params& p, LAS unsigned char* lds) {
    int tid_ = threadIdx.x; asm volatile("" : "+v"(tid_)); const int tid = tid_, lane = tid & 63, wid = tid >> 6, wm2 = wid >> 2, wn4 = wid & 3, c32 = lane & 31, h = lane >> 5;
    const int lrow = tid >> 2, lkc = (tid & 3) ^ ((tid >> 4) & 3);
    unsigned char* ws = p.ws;
    const bf16_t* xb = (const bf16_t*)(ws + OFF_XB); const bf16_t* wt = (const bf16_t*)(ws + OFF_WIN);
    float* stats = (float*)(ws + OFF_STATS);
    int mt2, jt2;
    for (int it = 0; xcd_tile256(it, 15, mt2, jt2); ++it) {
        unsigned ao[4], bo[4];
#pragma unroll
        for (int j = 0; j < 4; ++j) { const int r = lrow + 128 * (j & 1); ao[j] = (unsigned)((size_t)p1_token(2 * mt2 + (r >> 7), r & 127) * 1024 + lkc * 8); bo[j] = (unsigned)((size_t)(jt2 * 256 + r) * 1024 + lkc * 8); }
        f32x16 acc4[4][2]; zero_acc4(acc4);
        if (jt2 < 4) gemm_core256<false>(tid, lds, xb, ao, wt, bo, 1024, acc4); else gemm_core256<true>(tid, lds, xb, ao, wt, bo, 1024, acc4);
        int le_ = lane; asm volatile("" : "+v"(le_));
#pragma unroll
        for (int mh = 0; mh < 2; ++mh) {
            const int c32 = le_ & 31, h = le_ >> 5;
            const int mt = 2 * mt2 + wm2, jt = 2 * jt2 + (wn4 >> 1), wm = mh, wn = wn4 & 1;
            f32x16 (&acc)[2][2] = reinterpret_cast<f32x16 (&)[2][2]>(acc4[2 * mh]);
        if (jt < 8) {
            const int cp = (jt & 1) * 64 + wn * 32 + c32, ch = (jt >> 1) * 128 + cp;
#pragma unroll
            for (int mi = 0; mi < 2; ++mi)
#pragma unroll
                for (int q = 0; q < 4; ++q) {
                    const int i0 = wm * 64 + mi * 32 + 8 * q + 4 * h;
                    bf16_t* dst;
                    if (mt < 128) dst = (bf16_t*)(ws + OFF_W1P) + (((size_t)ch * 128 + mt) * 128 + i0) * 2;
                    else { const int idx = mt - 128, b = idx >> 5, pr = idx & 31; dst = (bf16_t*)(ws + OFF_W1S) + ((((size_t)b * 512 + ch) * 64 + 2 * pr + (i0 >> 6)) * 64 + (i0 & 63)) * 2; }
                    u32x4 w; w.x = pk(acc[mi][0][4 * q], acc[mi][1][4 * q]); w.y = pk(acc[mi][0][4 * q + 1], acc[mi][1][4 * q + 1]);
                    w.z = pk(acc[mi][0][4 * q + 2], acc[mi][1][4 * q + 2]); w.w = pk(acc[mi][0][4 * q + 3], acc[mi][1][4 * q + 3]);
                    *(u32x4*)dst = w;
                }
        } else {
#pragma unroll
            for (int mi = 0; mi < 2; ++mi) {
                const int tok = p1_token(mt, wm * 64 + mi * 32 + c32);
                if (jt < 13) {
                    const bool isq = jt < 11; bf16_t* dstrow = isq ? (bf16_t*)(ws + OFF_CQ) + (size_t)tok * 384 + (jt - 8) * 128 : (bf16_t*)(ws + OFF_CKV) + (size_t)tok * 256 + (jt - 11) * 128;
                    float ss = 0.f;
#pragma unroll
                    for (int ni = 0; ni < 2; ++ni) {
                        unsigned pv[8];
#pragma unroll
                        for (int q = 0; q < 4; ++q) {
                            const float v0 = acc[mi][ni][4 * q], v1 = acc[mi][ni][4 * q + 1], v2 = acc[mi][ni][4 * q + 2], v3 = acc[mi][ni][4 * q + 3];
                            ss += v0 * v0 + v1 * v1 + v2 * v2 + v3 * v3;
                            pv[2 * q] = pk(v0, v1); pv[2 * q + 1] = pk(v2, v3);
                        }
                        store_row32(dstrow + wn * 64 + ni * 32, pv, h);
                    }
                    ss += __shfl_xor(ss, 32);
                    if (h == 0) { if (isq) stats[(size_t)tok * 6 + (jt - 8) * 2 + wn] = ss; else stats[(size_t)6 * T + (size_t)tok * 4 + (jt - 11) * 2 + wn] = ss; }
                } else if (jt == 13) {
                    if (wn == 0) {
                        int ss_, S_, pos; tok_info(tok, ss_, S_, pos);
                        const f32x2* rope = (const f32x2*)(ws + OFF_ROPE) + (size_t)pos * 16;
                        bf16_t* dstrow = (bf16_t*)(ws + OFF_KPE) + (size_t)tok * 32;
#pragma unroll
                        for (int q = 0; q < 2; ++q) {
                            const int j0 = 8 * q + 4 * h;
                            float o1[4], o2[4];
#pragma unroll
                            for (int e = 0; e < 4; ++e) { const f32x2 cs = rope[j0 + e]; const float x1 = acc[mi][0][4 * q + e], x2 = acc[mi][0][4 * (q + 2) + e]; o1[e] = x1 * cs.x - x2 * cs.y; o2[e] = x2 * cs.x + x1 * cs.y; }
                            u32x2 w; w.x = pk(o1[0], o1[1]); w.y = pk(o1[2], o1[3]); *(u32x2*)(dstrow + j0) = w;
                            w.x = pk(o2[0], o2[1]); w.y = pk(o2[2], o2[3]); *(u32x2*)(dstrow + 16 + j0) = w;
                        }
                    }
                } else {
                    bf16_t* dstrow = (bf16_t*)p.out + (size_t)tok * 2048 + (jt - 14) * 128;
#pragma unroll
                    for (int ni = 0; ni < 2; ++ni) {
                        unsigned pv[8];
#pragma unroll
                        for (int q = 0; q < 4; ++q) {
                            float v[4];
#pragma unroll
                            for (int e = 0; e < 4; ++e) v[e] = __builtin_amdgcn_rcpf(1.f + __expf(-acc[mi][ni][4 * q + e]));
                            pv[2 * q] = pk(v[0], v[1]); pv[2 * q + 1] = pk(v[2], v[3]);
                        }
                        store_row32(dstrow + wn * 64 + ni * 32, pv, h);
                    }
                }
            }
        }
        }
    }
}

__device__ void phase_up(const Params& p, LAS unsigned char* lds_) {
    unsigned char* ws = p.ws;
    const float* stats = (const float*)(ws + OFF_STATS);
    {
        int t8_ = threadIdx.x; asm volatile("" : "+v"(t8_)); const int tid8 = t8_, lane8 = tid8 & 63, wid8 = tid8 >> 6, wm2 = wid8 >> 2, wn4 = wid8 & 3;
        const int lrow8 = tid8 >> 2, lkc8 = (tid8 & 3) ^ ((tid8 >> 4) & 3);
        for (int tile = blockIdx.x; tile < 576 + 768; tile += gridDim.x) {
            unsigned ao[4], bo[4];
            f32x16 acc4[4][2]; zero_acc4(acc4);
            if (tile < 576) {
                const int mt2 = tile / 3, jt2 = tile - mt2 * 3;
                const bf16_t* A = (const bf16_t*)(ws + OFF_CQ); const bf16_t* B = (const bf16_t*)(ws + OFF_WUQ);
#pragma unroll
                for (int j = 0; j < 4; ++j) { const int r = lrow8 + 128 * (j & 1); ao[j] = (unsigned)((size_t)(mt2 * 256 + r) * 384 + lkc8 * 8); bo[j] = (unsigned)((size_t)(jt2 * 256 + r) * 384 + lkc8 * 8); }
                gemm_core256<true>(tid8, lds_, A, ao, B, bo, 384, acc4);
        int le_ = lane8; asm volatile("" : "+v"(le_));
#pragma unroll
        for (int mh = 0; mh < 2; ++mh) {
            const int c32 = le_ & 31, h = le_ >> 5;
            const int mt = 2 * mt2 + wm2, jt = 2 * jt2 + (wn4 >> 1), wm = mh, wn = wn4 & 1;
            f32x16 (&acc)[2][2] = reinterpret_cast<f32x16 (&)[2][2]>(acc4[2 * mh]);
#pragma unroll
            for (int mi = 0; mi < 2; ++mi) {
                const int tok = mt * 128 + wm * 64 + mi * 32 + c32; int ss_, S_, pos; tok_info(tok, ss_, S_, pos);
                const f32x2 pa = *(const f32x2*)(stats + (size_t)tok * 6), pb = *(const f32x2*)(stats + (size_t)tok * 6 + 2), pc = *(const f32x2*)(stats + (size_t)tok * 6 + 4);
                const float rs = rsqrtf((((pa.x + pa.y) + (pb.x + pb.y)) + (pc.x + pc.y)) * (1.f / 384.f) + 1e-6f) * QSCALE;
#pragma unroll
                for (int ni = 0; ni < 2; ++ni) {
                    const int nt = jt * 4 + wn * 2 + ni, head = nt / 3, part = nt - 3 * head;
                    bf16_t* qd = (bf16_t*)(ws + OFF_Q) + ((size_t)ss_ * 8 + (size_t)head * S_ + pos) * 96;
                    if (part < 2) {
                        unsigned pv[8];
#pragma unroll
                        for (int q = 0; q < 4; ++q) { pv[2 * q] = pk(acc[mi][ni][4 * q] * rs, acc[mi][ni][4 * q + 1] * rs); pv[2 * q + 1] = pk(acc[mi][ni][4 * q + 2] * rs, acc[mi][ni][4 * q + 3] * rs); }
                        store_row32(qd + part * 32, pv, h);
                    } else {
                        const f32x2* rope = (const f32x2*)(ws + OFF_ROPE) + (size_t)pos * 16;
#pragma unroll
                        for (int q = 0; q < 2; ++q) {
                            const int j0 = 8 * q + 4 * h; float o1[4], o2[4];
#pragma unroll
                            for (int e = 0; e < 4; ++e) { const f32x2 cs = rope[j0 + e]; const float x1 = acc[mi][ni][4 * q + e] * rs, x2 = acc[mi][ni][4 * (q + 2) + e] * rs; o1[e] = x1 * cs.x - x2 * cs.y; o2[e] = x2 * cs.x + x1 * cs.y; }
                            u32x2 w; w.x = pk(o1[0], o1[1]); w.y = pk(o1[2], o1[3]); *(u32x2*)(qd + 64 + j0) = w;
                            w.x = pk(o2[0], o2[1]); w.y = pk(o2[2], o2[3]); *(u32x2*)(qd + 80 + j0) = w;
                        }
                    }
                }
            }
        }
            } else {
                const int t2 = tile - 576, mt2 = t2 >> 2, jt2 = t2 & 3;
                const bf16_t* A = (const bf16_t*)(ws + OFF_CKV); const bf16_t* B = (const bf16_t*)(ws + OFF_WUKV);
#pragma unroll
                for (int j = 0; j < 4; ++j) { const int r = lrow8 + 128 * (j & 1); ao[j] = (unsigned)((size_t)(mt2 * 256 + r) * 256 + lkc8 * 8); bo[j] = (unsigned)((size_t)(jt2 * 256 + r) * 256 + lkc8 * 8); }
                if (jt2 < 2) {
                    gemm_core256<true>(tid8, lds_, A, ao, B, bo, 256, acc4);
        int le_ = lane8; asm volatile("" : "+v"(le_));
#pragma unroll
        for (int mh = 0; mh < 2; ++mh) {
            const int c32 = le_ & 31, h = le_ >> 5;
            const int mt = 2 * mt2 + wm2, jt = 2 * jt2 + (wn4 >> 1), wm = mh, wn = wn4 & 1;
            f32x16 (&acc)[2][2] = reinterpret_cast<f32x16 (&)[2][2]>(acc4[2 * mh]);
                const int head = 2 * jt + wn;
#pragma unroll
                for (int mi = 0; mi < 2; ++mi) {
                    const int tok = mt * 128 + wm * 64 + mi * 32 + c32; int ss_, S_, pos; tok_info(tok, ss_, S_, pos);
                    const f32x4 pv = *(const f32x4*)(stats + (size_t)6 * T + (size_t)tok * 4);
                    const float rs = rsqrtf(((pv[0] + pv[1]) + (pv[2] + pv[3])) * (1.f / 256.f) + 1e-6f);
                    bf16_t* kd = (bf16_t*)(ws + OFF_K) + ((size_t)ss_ * 8 + (size_t)head * S_ + pos) * 96;
#pragma unroll
                    for (int ni = 0; ni < 2; ++ni) {
                        unsigned pv[8];
#pragma unroll
                        for (int q = 0; q < 4; ++q) { pv[2 * q] = pk(acc[mi][ni][4 * q] * rs, acc[mi][ni][4 * q + 1] * rs); pv[2 * q + 1] = pk(acc[mi][ni][4 * q + 2] * rs, acc[mi][ni][4 * q + 3] * rs); }
                        store_row32(kd + ni * 32, pv, h);
                    }
                }
        }
                } else {
                    gemm_core256<false>(tid8, lds_, A, ao, B, bo, 256, acc4);
        int le_ = lane8; asm volatile("" : "+v"(le_));
#pragma unroll
        for (int mh = 0; mh < 2; ++mh) {
            const int c32 = le_ & 31, h = le_ >> 5;
            const int mt = 2 * mt2 + wm2, jt = 2 * jt2 + (wn4 >> 1), wm = mh, wn = wn4 & 1;
            f32x16 (&acc)[2][2] = reinterpret_cast<f32x16 (&)[2][2]>(acc4[2 * mh]);
                const int head = 2 * (jt - 4) + wn;
#pragma unroll
                for (int mi = 0; mi < 2; ++mi)
#pragma unroll
                    for (int q = 0; q < 4; ++q) {
                        const int tok0 = mt * 128 + wm * 64 + mi * 32 + 8 * q + 4 * h; int ss_, S_, pos; tok_info(tok0, ss_, S_, pos);
                        const float* sp = stats + (size_t)6 * T + (size_t)tok0 * 4;
                        const f32x4 q0 = *(const f32x4*)sp, q1 = *(const f32x4*)(sp + 4), q2 = *(const f32x4*)(sp + 8), q3 = *(const f32x4*)(sp + 12);
                        const float r0 = rsqrtf(((q0[0] + q0[1]) + (q0[2] + q0[3])) * (1.f / 256.f) + 1e-6f), r1 = rsqrtf(((q1[0] + q1[1]) + (q1[2] + q1[3])) * (1.f / 256.f) + 1e-6f), r2 = rsqrtf(((q2[0] + q2[1]) + (q2[2] + q2[3])) * (1.f / 256.f) + 1e-6f), r3 = rsqrtf(((q3[0] + q3[1]) + (q3[2] + q3[3])) * (1.f / 256.f) + 1e-6f);
#pragma unroll
                        for (int ni = 0; ni < 2; ++ni) {
                            const int d = ni * 32 + c32;
                            bf16_t* vd = (bf16_t*)(ws + OFF_VT) + ((size_t)ss_ * 8 + (size_t)head * S_) * 64 + (size_t)d * S_ + pos;
                            u32x2 w; w.x = pk(acc[mi][ni][4 * q] * r0, acc[mi][ni][4 * q + 1] * r1); w.y = pk(acc[mi][ni][4 * q + 2] * r2, acc[mi][ni][4 * q + 3] * r3);
                            *(u32x2*)vd = w;
                        }
                    }
        }
                }
            }
        }
    }
    int tid_ = threadIdx.x; asm volatile("" : "+v"(tid_)); const int half = tid_ >> 8, tid = tid_ & 255, lane = tid & 63, wid = tid >> 6, wm = wid >> 1, wn = wid & 1, c32 = lane & 31, h = lane >> 5;
    const int lrow = tid >> 3, lkc = (tid & 7) ^ ((tid >> 4) & 7);
    LAS unsigned char* lds = lds_ + half * 65536;
    const int NQ = 0, NKV = 0, NFP = 1024, NFS = 2048, NTOT = NFP + NFS;
    for (int t0 = blockIdx.x * 2; t0 < NTOT; t0 += gridDim.x * 2) {
        const int tile = t0 + half;
        unsigned ao[4], bo[4];
        f32x16 acc[2][2]; zero_acc(acc);
        {
            const int t3 = tile - NQ - NKV; const bool prm = t3 < NFP;
            int K, jn, rowtile; const bf16_t* A; const bf16_t* B;
            if (prm) { rowtile = t3 >> 1; jn = t3 & 1; K = 256; A = (const bf16_t*)(ws + OFF_W1P); B = (const bf16_t*)(ws + OFF_FA128); }
            else { rowtile = t3 - NFP; jn = 0; K = 128; A = (const bf16_t*)(ws + OFF_W1S); B = (const bf16_t*)(ws + OFF_FA64); }
#pragma unroll
            for (int j = 0; j < 4; ++j) { const int i = lrow + 32 * j; ao[j] = (unsigned)(((size_t)rowtile * 128 + i) * K + lkc * 8); bo[j] = (unsigned)((size_t)(jn * 128 + i) * K + lkc * 8); }
            gemm_core<false>(tid, lds, A, ao, B, bo, K, acc);
            const int k1 = (jn * 2 + wn) * 32 + c32;
#pragma unroll
            for (int mi = 0; mi < 2; ++mi)
#pragma unroll
                for (int q = 0; q < 4; ++q) {
                    const int i0 = wm * 64 + mi * 32 + 8 * q + 4 * h;
                    int n2b; bf16_t* dst; float invS;
                    if (prm) { n2b = i0; dst = (bf16_t*)(ws + OFF_A2P) + (((size_t)k1 * 512 + rowtile) * 128 + n2b) * 2; invS = 1.f / 16384.f; }
                    else { const int b = rowtile >> 8, ch = 2 * (rowtile & 255) + (i0 >> 6); n2b = i0 & 63; dst = (bf16_t*)(ws + OFF_A2S) + ((((size_t)b * 64 + k1) * 512 + ch) * 64 + n2b) * 2; invS = 1.f / 4096.f; }
                    u32x4 w; unsigned wv[4];
#pragma unroll
                    for (int e = 0; e < 4; ++e) {
                        const float rev = (float)(k1 * (n2b + e)) * invS; const float c = cos_rev(rev), s = sin_rev(rev);
                        const float re = acc[mi][0][4 * q + e], im = acc[mi][1][4 * q + e];
                        wv[e] = pk(re * c + im * s, im * c - re * s);
                    }
                    w.x = wv[0]; w.y = wv[1]; w.z = wv[2]; w.w = wv[3];
                    *(u32x4*)dst = w;
                }
        }
    }
    { const size_t gtid = ((size_t)blockIdx.x * 2 + half) * 256 + tid, gth = (size_t)gridDim.x * 512;
      const bf16_t* kpe = (const bf16_t*)(ws + OFF_KPE); bf16_t* Kb = (bf16_t*)(ws + OFF_K);
      for (size_t i = gtid; i < (size_t)T * 32; i += gth) {
          const int c = (int)(i & 3), hh = (int)((i >> 2) & 7), tok = (int)(i >> 5); int ss_, S_, pos; tok_info(tok, ss_, S_, pos);
          const u32x4 v = *(const u32x4*)(kpe + (size_t)tok * 32 + c * 8);
          *(u32x4*)(Kb + ((size_t)ss_ * 8 + (size_t)hh * S_ + pos) * 96 + 64 + c * 8) = v; } }
}

__device__ __forceinline__ void attn_item(const int tid, LAS unsigned char* lds, const bf16_t* __restrict__ Qb, const bf16_t* __restrict__ Kb, const bf16_t* __restrict__ Vb, bf16_t* __restrict__ Ob, int S, int q0) {
    const int lane = tid & 63, w = tid >> 6, c32 = lane & 31, h = lane >> 5;
    bf16x8 qf[2][6];
#pragma unroll
    for (int u = 0; u < 2; ++u) { const bf16_t* qp = Qb + (size_t)(q0 + 64 * w + 32 * u + c32) * 96 + h * 8;
#pragma unroll
      for (int kk = 0; kk < 6; ++kk) qf[u][kk] = *(const bf16x8*)(qp + kk * 16); }
    f32x16 o[2][2];
#pragma unroll
    for (int u = 0; u < 2; ++u)
#pragma unroll
        for (int d = 0; d < 2; ++d)
#pragma unroll
            for (int e = 0; e < 16; ++e) o[u][d][e] = 0.f;
    float m_run[2] = {0.f, 0.f}, l_run[2] = {0.f, 0.f};
    LAS unsigned char* sK = lds; LAS unsigned char* sV = lds + 2 * 64 * KSTR;
    const int nkt = S >> 6;
    u32x4 rk[2], rv;
    rk[1].x = rk[1].y = rk[1].z = rk[1].w = 0u;
#define ATT_KOFS(c_) (((c_) / 12) * KSTR + ((c_) % 12) * 16)
#define ATT_VOFS(c_) (((c_) >> 3) * VSTR + ((c_) & 7) * 16)
#define ATT_VSRC(c_) ((unsigned)((c_) >> 3) * (unsigned)S + (unsigned)(((c_) & 7) * 8))
    rk[0] = *(const u32x4*)(Kb + (size_t)tid * 8);
    if (tid < 256) rk[1] = *(const u32x4*)(Kb + (size_t)(tid + 512) * 8);
    rv = *(const u32x4*)(Vb + ATT_VSRC(tid));
    __syncthreads();
    *(LAS u32x4*)(sK + ATT_KOFS(tid)) = rk[0];
    if (tid < 256) *(LAS u32x4*)(sK + ATT_KOFS(tid + 512)) = rk[1];
    *(LAS u32x2*)(sV + ATT_VOFS(tid)) = (u32x2){rv.x, rv.y}; *(LAS u32x2*)(sV + ATT_VOFS(tid) + 8) = (u32x2){rv.z, rv.w};
    __syncthreads();
#pragma unroll 1
    for (int kt = 0; kt < nkt; ++kt) {
        const int cur = kt & 1;
        LAS unsigned char* cK = sK + cur * 64 * KSTR; LAS unsigned char* cV = sV + cur * 64 * VSTR;
        int tl_ = tid; asm volatile("" : "+v"(tl_));
#pragma unroll
        for (int t = 0; t < 2; ++t) {
            f32x16 x[2];
#pragma unroll
            for (int u = 0; u < 2; ++u)
#pragma unroll
                for (int e = 0; e < 16; ++e) x[u][e] = -m_run[u];
#pragma unroll
            for (int kk = 0; kk < 6; ++kk) {
                const bf16x8 kf = *(const LAS bf16x8*)(cK + (32 * t + c32) * KSTR + kk * 32 + h * 16);
                x[0] = mfma32(kf, qf[0][kk], x[0]); x[1] = mfma32(kf, qf[1][kk], x[1]);
            }
            if (t == 0) {
                __builtin_amdgcn_sched_barrier(0);
                if (kt + 1 < nkt) {
                    rk[0] = *(const u32x4*)(Kb + (size_t)(kt + 1) * 64 * 96 + (size_t)tl_ * 8);
                    if (tl_ < 256) rk[1] = *(const u32x4*)(Kb + (size_t)(kt + 1) * 64 * 96 + (size_t)(tl_ + 512) * 8);
                    rv = *(const u32x4*)(Vb + ATT_VSRC(tl_) + (size_t)(kt + 1) * 64);
                }
            }
            union PF { u32x4 u; bf16x8 b; } pf[2][2];
#pragma unroll
            for (int u = 0; u < 2; ++u) {
                float mx = fmaxf(fmaxf(x[u][0], x[u][1]), x[u][2]);
#pragma unroll
                for (int e = 3; e < 15; e += 2) mx = fmaxf(fmaxf(mx, x[u][e]), x[u][e + 1]);
                mx = fmaxf(mx, x[u][15]);
                const bool first = (kt == 0) && (t == 0);
                if (first || __builtin_amdgcn_ballot_w64(mx > 8.f) != 0ull) {
                    mx = fmaxf(mx, __shfl_xor(mx, 32));
                    const float d = first ? mx : fmaxf(mx, 0.f);
                    const float alpha = first ? 1.f : __builtin_amdgcn_exp2f(-d);
                    m_run[u] += d; l_run[u] *= alpha;
#pragma unroll
                    for (int e = 0; e < 16; ++e) { o[u][0][e] *= alpha; o[u][1][e] *= alpha; x[u][e] -= d; }
                }
                f32x2 rs2; rs2.x = 0.f; rs2.y = 0.f;
#pragma unroll
                for (int e = 0; e < 16; e += 2) { x[u][e] = __builtin_amdgcn_exp2f(x[u][e]); x[u][e + 1] = __builtin_amdgcn_exp2f(x[u][e + 1]); f32x2 pv; pv.x = x[u][e]; pv.y = x[u][e + 1]; rs2 += pv; }
                l_run[u] += rs2.x + rs2.y;
#pragma unroll
                for (int s2 = 0; s2 < 2; ++s2) { pf[u][s2].u.x = pk(x[u][8 * s2], x[u][8 * s2 + 1]); pf[u][s2].u.y = pk(x[u][8 * s2 + 2], x[u][8 * s2 + 3]);
                    pf[u][s2].u.z = pk(x[u][8 * s2 + 4], x[u][8 * s2 + 5]); pf[u][s2].u.w = pk(x[u][8 * s2 + 6], x[u][8 * s2 + 7]); }
            }
#pragma unroll
            for (int s2 = 0; s2 < 2; ++s2) {
                const int kb = (32 * t + 16 * s2 + 4 * h) * 2;
                union { u32x4 u; bf16x8 b; } v0, v1;
                { const u32x2 a = *(const LAS u32x2*)(cV + c32 * VSTR + kb), b = *(const LAS u32x2*)(cV + c32 * VSTR + kb + 16); v0.u.x = a.x; v0.u.y = a.y; v0.u.z = b.x; v0.u.w = b.y; }
                { const u32x2 a = *(const LAS u32x2*)(cV + (32 + c32) * VSTR + kb), b = *(const LAS u32x2*)(cV + (32 + c32) * VSTR + kb + 16); v1.u.x = a.x; v1.u.y = a.y; v1.u.z = b.x; v1.u.w = b.y; }
                o[0][0] = mfma32(v0.b, pf[0][s2].b, o[0][0]); o[0][1] = mfma32(v1.b, pf[0][s2].b, o[0][1]);
                o[1][0] = mfma32(v0.b, pf[1][s2].b, o[1][0]); o[1][1] = mfma32(v1.b, pf[1][s2].b, o[1][1]);
            }
        }
        if (kt + 1 < nkt) {
            LAS unsigned char* nK = sK + (cur ^ 1) * 64 * KSTR; LAS unsigned char* nV = sV + (cur ^ 1) * 64 * VSTR;
            *(LAS u32x4*)(nK + ATT_KOFS(tl_)) = rk[0];
            if (tl_ < 256) *(LAS u32x4*)(nK + ATT_KOFS(tl_ + 512)) = rk[1];
            *(LAS u32x2*)(nV + ATT_VOFS(tl_)) = (u32x2){rv.x, rv.y}; *(LAS u32x2*)(nV + ATT_VOFS(tl_) + 8) = (u32x2){rv.z, rv.w};
        }
        __syncthreads();
    }
#pragma unroll
    for (int u = 0; u < 2; ++u) {
        const float l = l_run[u] + __shfl_xor(l_run[u], 32);
        const float inv = 1.f / l;
        bf16_t* orow = Ob + (size_t)(64 * w + 32 * u + c32) * 512;
        unsigned pv0[8], pv1[8];
#pragma unroll
        for (int g = 0; g < 4; ++g) {
            pv0[2 * g] = pk(o[u][0][4 * g] * inv, o[u][0][4 * g + 1] * inv); pv0[2 * g + 1] = pk(o[u][0][4 * g + 2] * inv, o[u][0][4 * g + 3] * inv);
            pv1[2 * g] = pk(o[u][1][4 * g] * inv, o[u][1][4 * g + 1] * inv); pv1[2 * g + 1] = pk(o[u][1][4 * g + 2] * inv, o[u][1][4 * g + 3] * inv);
        }
        store_row32(orow, pv0, h); store_row32(orow + 32, pv1, h);
    }
}

__device__ void phase_attn(const Params& p, LAS unsigned char* lds_) {
    int tid_ = threadIdx.x; asm volatile("" : "+v"(tid_)); const int half = tid_ >> 8, tid = tid_ & 255;
    LAS unsigned char* lds = lds_ + half * 65536;
    unsigned char* ws = p.ws;
    const int G = gridDim.x, bid = blockIdx.x;
    const int xcd = bid & 7, local = bid >> 3, nloc = (G - xcd + 7) >> 3;
    const bf16_t* Q = (const bf16_t*)(ws + OFF_Q); const bf16_t* Kp = (const bf16_t*)(ws + OFF_K); const bf16_t* VT = (const bf16_t*)(ws + OFF_VT); bf16_t* O = (bf16_t*)(ws + OFF_O);
    const int tid8 = tid_;
    for (int qt = local; qt < 32; qt += nloc) {
        const int head = xcd; const size_t base = (size_t)head * 16384;
        attn_item(tid8, lds_, Q + base * 96, Kp + base * 96, VT + base * 64, O + (size_t)(qt * 512) * 512 + head * 64, 16384, qt * 512);
    }
    for (int it = local; it < 64; it += nloc) {
        const int bh = xcd * 8 + (it >> 3), qt = it & 7, b = bh >> 3, head = bh & 7;
        const size_t ss = TP + (size_t)b * 4096; const size_t base = ss * 8 + (size_t)head * 4096;
        attn_item(tid8, lds_, Q + base * 96, Kp + base * 96, VT + base * 64, O + (ss + qt * 512) * 512 + head * 64, 4096, qt * 512);
    }
    __syncthreads();
    int tb_ = threadIdx.x; asm volatile("" : "+v"(tb_)); const int tidb = tb_ & 255, lane = tidb & 63, wid = tidb >> 6, wm = wid >> 1, wn = wid & 1, c32 = lane & 31, h = lane >> 5;
    const int lrow = tidb >> 3, lkc = (tidb & 7) ^ ((tidb >> 4) & 7);
    for (int t0 = bid * 2; t0 < 512 + 2048; t0 += G * 2) {
        const int tile = t0 + half;
        const bool prm = tile < 512; const int fb = prm ? tile : tile - 512;
        const int K = prm ? 256 : 128;
        const bf16_t* A = (const bf16_t*)(ws + (prm ? OFF_A2P : OFF_A2S)); const bf16_t* B = (const bf16_t*)(ws + (prm ? OFF_FB128 : OFF_FB64));
        unsigned ao[4], bo[4];
#pragma unroll
        for (int j = 0; j < 4; ++j) { const int i = lrow + 32 * j; ao[j] = (unsigned)(((size_t)fb * 128 + i) * K + lkc * 8); bo[j] = (unsigned)((size_t)i * K + lkc * 8); }
        f32x16 acc[2][2]; zero_acc(acc);
        gemm_core<false>(tidb, lds, A, ao, B, bo, K, acc);
        const int g = fb & 3; int k1, R; size_t ss; float scale;
        if (prm) { k1 = fb >> 2; R = 128; ss = 0; scale = 1.f / (128.f * 11.313708498984761f); }
        else { const int bk = fb >> 2; k1 = bk & 63; R = 64; ss = TP + (size_t)(bk >> 6) * 4096; scale = 1.f / (64.f * 11.313708498984761f); }
        if (prm || wn == 0) {
#pragma unroll
            for (int ni = 0; ni < 2; ++ni) {
                const int k2 = wn * 64 + ni * 32 + c32;
                bf16_t* frow = (bf16_t*)(ws + OFF_FB) + (ss + k1 + (size_t)R * k2) * 512 + g * 128;
#pragma unroll
                for (int mi = 0; mi < 2; ++mi)
#pragma unroll
                    for (int q = 0; q < 4; ++q) {
                        u32x2 w; w.x = pk(acc[mi][ni][4 * q] * scale, acc[mi][ni][4 * q + 1] * scale); w.y = pk(acc[mi][ni][4 * q + 2] * scale, acc[mi][ni][4 * q + 3] * scale);
                        *(u32x2*)(frow + wm * 64 + mi * 32 + 8 * q + 4 * h) = w;
                    }
            }
        }
    }
}

__device__ void phase_merge(const Params& p, LAS unsigned char* lds) {
    int tid_ = threadIdx.x; asm volatile("" : "+v"(tid_)); const int tid = tid_, lane = tid & 63, wid = tid >> 6, wm2 = wid >> 2, wn4 = wid & 3, c32 = lane & 31, h = lane >> 5;
    const int lrow = tid >> 2, lkc = (tid & 3) ^ ((tid >> 4) & 3);
    unsigned char* ws = p.ws;
    const bf16_t* Fb = (const bf16_t*)(ws + OFF_FB); const bf16_t* Ob = (const bf16_t*)(ws + OFF_O);
    const bf16_t* WF = (const bf16_t*)(ws + OFF_WF); const bf16_t* WA = (const bf16_t*)(ws + OFF_WAT);
    const bf16_t* gates = (const bf16_t*)p.out; bf16_t* MH = (bf16_t*)(ws + OFF_MH);
    int mt2, jt2;
    for (int it = 0; xcd_tile256(it, 4, mt2, jt2); ++it) {
        unsigned ao[4], bo[4];
#pragma unroll
        for (int j = 0; j < 4; ++j) { const int r = lrow + 128 * (j & 1); ao[j] = (unsigned)((size_t)(mt2 * 256 + r) * 512 + lkc * 8); bo[j] = (unsigned)((size_t)(jt2 * 256 + r) * 512 + lkc * 8); }
        f32x16 acc4[4][2]; zero_acc4(acc4);
        gemm_core256<true>(tid, lds, Fb, ao, WF, bo, 512, acc4);
        int le_ = lane; asm volatile("" : "+v"(le_));
#pragma unroll
        for (int mh = 0; mh < 2; ++mh) {
            const int c32 = le_ & 31, h = le_ >> 5;
            const int mt = 2 * mt2 + wm2, jt = 2 * jt2 + (wn4 >> 1), wm = mh, wn = wn4 & 1;
            f32x16 (&acc)[2][2] = reinterpret_cast<f32x16 (&)[2][2]>(acc4[2 * mh]);
#pragma unroll
        for (int mi = 0; mi < 2; ++mi) {
            const int tok = mt * 128 + wm * 64 + mi * 32 + c32;
#pragma unroll
            for (int ni = 0; ni < 2; ++ni) {
                unsigned pv[8], gq[8];
                load_row32(gates + (size_t)tok * 2048 + jt * 128 + wn * 64 + ni * 32, gq, h);
#pragma unroll
                for (int q = 0; q < 4; ++q) {
                    u32x2 gv; gv.x = gq[2 * q]; gv.y = gq[2 * q + 1];
                    pv[2 * q] = pk(acc[mi][ni][4 * q] * __uint_as_float(gv.x << 16), acc[mi][ni][4 * q + 1] * __uint_as_float(gv.x & 0xffff0000u));
                    pv[2 * q + 1] = pk(acc[mi][ni][4 * q + 2] * __uint_as_float(gv.y << 16), acc[mi][ni][4 * q + 3] * __uint_as_float(gv.y & 0xffff0000u));
                }
                store_row32(MH + (size_t)tok * 1024 + jt * 128 + wn * 64 + ni * 32, pv, h);
            }
        }
        }
        zero_acc4(acc4);
        gemm_core256<true>(tid, lds, Ob, ao, WA, bo, 512, acc4);
        le_ = lane; asm volatile("" : "+v"(le_));
#pragma unroll
        for (int mh = 0; mh < 2; ++mh) {
            const int c32 = le_ & 31, h = le_ >> 5;
            const int mt = 2 * mt2 + wm2, jt = 2 * jt2 + (wn4 >> 1), wm = mh, wn = wn4 & 1;
            f32x16 (&acc)[2][2] = reinterpret_cast<f32x16 (&)[2][2]>(acc4[2 * mh]);
#pragma unroll
        for (int mi = 0; mi < 2; ++mi) {
            const int tok = mt * 128 + wm * 64 + mi * 32 + c32;
#pragma unroll
            for (int ni = 0; ni < 2; ++ni) {
                unsigned pv[8], gq[8], mq[8];
                load_row32(gates + (size_t)tok * 2048 + 1024 + jt * 128 + wn * 64 + ni * 32, gq, h);
                load_row32(MH + (size_t)tok * 1024 + jt * 128 + wn * 64 + ni * 32, mq, h);
#pragma unroll
                for (int q = 0; q < 4; ++q) {
                    u32x2 gv; gv.x = gq[2 * q]; gv.y = gq[2 * q + 1];
                    u32x2 pm; pm.x = mq[2 * q]; pm.y = mq[2 * q + 1];
                    const float m0 = __uint_as_float(pm.x << 16) + acc[mi][ni][4 * q] * __uint_as_float(gv.x << 16), m1 = __uint_as_float(pm.x & 0xffff0000u) + acc[mi][ni][4 * q + 1] * __uint_as_float(gv.x & 0xffff0000u);
                    const float m2 = __uint_as_float(pm.y << 16) + acc[mi][ni][4 * q + 2] * __uint_as_float(gv.y << 16), m3 = __uint_as_float(pm.y & 0xffff0000u) + acc[mi][ni][4 * q + 3] * __uint_as_float(gv.y & 0xffff0000u);
                    pv[2 * q] = pk(m0, m1); pv[2 * q + 1] = pk(m2, m3);
                }
                store_row32(MH + (size_t)tok * 1024 + jt * 128 + wn * 64 + ni * 32, pv, h);
            }
        }
        }
    }
}

template <int WHICH>
__device__ void phase_resgemm(const Params& p, LAS unsigned char* lds) {
    int tid_ = threadIdx.x; asm volatile("" : "+v"(tid_)); const int tid = tid_, lane = tid & 63, wid = tid >> 6, wm2 = wid >> 2, wn4 = wid & 3, c32 = lane & 31, h = lane >> 5;
    const int lrow = tid >> 2, lkc = (tid & 3) ^ ((tid >> 4) & 3);
    unsigned char* ws = p.ws;
    const int K = WHICH == 0 ? 1024 : 2816;
    const bf16_t* A = (const bf16_t*)(ws + (WHICH == 0 ? OFF_MH : OFF_ACT)); const bf16_t* B = (const bf16_t*)(ws + (WHICH == 0 ? OFF_WO : OFF_WD));
    f32x2* st = (f32x2*)((float*)(ws + OFF_STATS) + (size_t)10 * T);
    int mt2, jt2;
    for (int it = 0; xcd_tile256(it, 4, mt2, jt2); ++it) {
        unsigned ao[4], bo[4];
#pragma unroll
        for (int j = 0; j < 4; ++j) { const int r = lrow + 128 * (j & 1); ao[j] = (unsigned)((size_t)(mt2 * 256 + r) * K + lkc * 8); bo[j] = (unsigned)((size_t)(jt2 * 256 + r) * K + lkc * 8); }
        f32x16 acc4[4][2]; zero_acc4(acc4);
        gemm_core256<true>(tid, lds, A, ao, B, bo, K, acc4);
        int le_ = lane; asm volatile("" : "+v"(le_));
        {
            LAS float* Tw = (LAS float*)(lds + (tid >> 6) * 16384);
            const int c32 = le_ & 31, h = le_ >> 5, g4 = le_ >> 4, c16 = le_ & 15;
            const int mt = 2 * mt2 + wm2, jt = 2 * jt2 + (wn4 >> 1), wn = wn4 & 1;
#pragma unroll
            for (int mh = 0; mh < 2; ++mh) {
#pragma unroll
                for (int mi = 0; mi < 2; ++mi)
#pragma unroll
                    for (int ni = 0; ni < 2; ++ni)
#pragma unroll
                        for (int q = 0; q < 4; ++q) {
                            const int row = mi * 32 + c32, chunk = (ni * 8 + 2 * q + h) ^ (row & 15);
                            f32x4 v; v[0] = acc4[2 * mh + mi][ni][4 * q]; v[1] = acc4[2 * mh + mi][ni][4 * q + 1]; v[2] = acc4[2 * mh + mi][ni][4 * q + 2]; v[3] = acc4[2 * mh + mi][ni][4 * q + 3];
                            *(LAS f32x4*)(Tw + row * 64 + chunk * 4) = v;
                        }
                const int tok0 = mt * 128 + mh * 64, col = jt * 128 + wn * 64 + 4 * c16;
#pragma unroll
                for (int p_ = 0; p_ < 16; ++p_) {
                    const int row = 4 * p_ + g4, tok = tok0 + row;
                    LAS float* cp = Tw + row * 64 + ((c16 ^ (row & 15)) * 4);
                    const f32x4 v = *(const LAS f32x4*)cp;
                    const float* res = WHICH == 0 ? xrow(p, tok) : p.out + (size_t)tok * 1024;
                    const f32x4 r = *(const f32x4*)(res + col);
                    f32x4 y; y[0] = ALPHA * r[0] + v[0]; y[1] = ALPHA * r[1] + v[1]; y[2] = ALPHA * r[2] + v[2]; y[3] = ALPHA * r[3] + v[3];
                    *(f32x4*)(p.out + (size_t)tok * 1024 + col) = y;
                    f32x2 sp; sp.x = (y[0] + y[1]) + (y[2] + y[3]); sp.y = (y[0] * y[0] + y[1] * y[1]) + (y[2] * y[2] + y[3] * y[3]);
                    *(LAS f32x2*)cp = sp;
                }
                {
                    const int row = le_; float s1 = 0.f, s2 = 0.f;
#pragma unroll
                    for (int j = 0; j < 16; ++j) { const f32x2 sp = *(const LAS f32x2*)(Tw + row * 64 + (((j + row) & 15) * 4)); s1 += sp.x; s2 += sp.y; }
                    f32x2 sv; sv.x = s1; sv.y = s2; st[(size_t)(tok0 + row) * 16 + jt * 2 + wn] = sv;
                }
            }
        }
        __syncthreads();
    }
}

template <int WHICH>
__device__ void phase_ln(const Params& p) {
    int tid_ = threadIdx.x; asm volatile("" : "+v"(tid_)); const int tid = tid_, lane = tid & 63, wid = tid >> 6;
    unsigned char* ws = p.ws;
    const f32x2* st = (const f32x2*)((const float*)(ws + OFF_STATS) + (size_t)10 * T);
    const float* gam = WHICH == 0 ? p.ln1_g : p.ln2_g; const float* bet = WHICH == 0 ? p.ln1_b : p.ln2_b;
    bf16_t* MH = (bf16_t*)(ws + OFF_MH);
    const int stride = gridDim.x * 8;
    for (int row0 = blockIdx.x * 8 + wid; row0 < T; row0 += 2 * stride) {
        const int nr = (row0 + stride < T) ? 2 : 1;
        f32x4 v[2][4]; float mean[2], rstd[2];
#pragma unroll
        for (int u = 0; u < 2; ++u) {
            const int row = (u < nr) ? row0 + u * stride : row0;
            const f32x2 pv = st[(size_t)row * 16 + (lane & 15)]; float s1 = pv.x, s2 = pv.y;
            s1 += __shfl_xor(s1, 8); s2 += __shfl_xor(s2, 8); s1 += __shfl_xor(s1, 4); s2 += __shfl_xor(s2, 4); s1 += __shfl_xor(s1, 2); s2 += __shfl_xor(s2, 2); s1 += __shfl_xor(s1, 1); s2 += __shfl_xor(s2, 1);
            mean[u] = s1 * (1.f / 1024.f); const float var = fmaxf(s2 * (1.f / 1024.f) - mean[u] * mean[u], 0.f); rstd[u] = rsqrtf(var + 1e-5f);
            const float* r = p.out + (size_t)row * 1024;
#pragma unroll
            for (int j = 0; j < 4; ++j) v[u][j] = *(const f32x4*)(r + j * 256 + lane * 4);
        }
#pragma unroll
        for (int u = 0; u < 2; ++u) {
            if (u < nr) {
                const int row = row0 + u * stride;
                float* r = p.out + (size_t)row * 1024;
#pragma unroll
                for (int j = 0; j < 4; ++j) {
                    const int col = j * 256 + lane * 4;
                    const f32x4 g = *(const f32x4*)(gam + col), b = *(const f32x4*)(bet + col);
                    f32x4 y; y[0] = (v[u][j][0] - mean[u]) * rstd[u] * g[0] + b[0]; y[1] = (v[u][j][1] - mean[u]) * rstd[u] * g[1] + b[1]; y[2] = (v[u][j][2] - mean[u]) * rstd[u] * g[2] + b[2]; y[3] = (v[u][j][3] - mean[u]) * rstd[u] * g[3] + b[3];
                    *(f32x4*)(r + col) = y;
                    if (WHICH == 0) { u32x2 w; w.x = pk(y[0], y[1]); w.y = pk(y[2], y[3]); *(u32x2*)(MH + (size_t)row * 1024 + col) = w; }
                }
            }
        }
    }
}

__device__ void phase_ffn_up(const Params& p, LAS unsigned char* lds) {
    int tid_ = threadIdx.x; asm volatile("" : "+v"(tid_)); const int tid = tid_, lane = tid & 63, wid = tid >> 6, wm2 = wid >> 2, wn4 = wid & 3, c32 = lane & 31, h = lane >> 5;
    const int lrow = tid >> 2, lkc = (tid & 3) ^ ((tid >> 4) & 3);
    unsigned char* ws = p.ws;
    const bf16_t* A = (const bf16_t*)(ws + OFF_MH); const bf16_t* B = (const bf16_t*)(ws + OFF_WGU); bf16_t* ACT = (bf16_t*)(ws + OFF_ACT);
    int mt2, jt2;
    for (int it = 0; xcd_tile256(it, 22, mt2, jt2); ++it) {
        unsigned ao[4], bo[4];
#pragma unroll
        for (int j = 0; j < 4; ++j) { const int r = lrow + 128 * (j & 1); ao[j] = (unsigned)((size_t)(mt2 * 256 + r) * 1024 + lkc * 8); bo[j] = (unsigned)((size_t)(jt2 * 256 + r) * 1024 + lkc * 8); }
        f32x16 acc4[4][2]; zero_acc4(acc4);
        gemm_core256<true>(tid, lds, A, ao, B, bo, 1024, acc4);
        int le_ = lane; asm volatile("" : "+v"(le_));
#pragma unroll
        for (int mh = 0; mh < 2; ++mh) {
            const int c32 = le_ & 31, h = le_ >> 5;
            const int mt = 2 * mt2 + wm2, jt = 2 * jt2 + (wn4 >> 1), wm = mh, wn = wn4 & 1;
            f32x16 (&acc)[2][2] = reinterpret_cast<f32x16 (&)[2][2]>(acc4[2 * mh]);
#pragma unroll
        for (int mi = 0; mi < 2; ++mi) {
            const int tok = mt * 128 + wm * 64 + mi * 32 + c32;
            bf16_t* arow = ACT + (size_t)tok * 2816 + (jt * 2 + wn) * 32;
            unsigned pv[8];
#pragma unroll
            for (int q = 0; q < 4; ++q) {
                float v[4];
#pragma unroll
                for (int e = 0; e < 4; ++e) { const float g = acc[mi][0][4 * q + e], u = acc[mi][1][4 * q + e]; v[e] = g * u * __builtin_amdgcn_rcpf(1.f + __expf(-g)); }
                pv[2 * q] = pk(v[0], v[1]); pv[2 * q + 1] = pk(v[2], v[3]);
            }
            store_row32(arow, pv, h);
        }
        }
    }
}

__global__ void __launch_bounds__(512, 2) mega(Params p) {
    __shared__ __attribute__((aligned(16))) unsigned char smem[LDS_BYTES];
    LAS unsigned char* lds = (LAS unsigned char*)smem;
    cg::grid_group grid = cg::this_grid();
    const int lo = p.ph_lo, hi = p.ph_hi;
#if !defined(PHASE_MASK) || ((PHASE_MASK >> 0) & 1)
    if (lo <= 0 && 0 < hi) { phase_prep(p, lds);
#if defined(DUP_PHASE) && DUP_PHASE == 0
        grid.sync(); phase_prep(p, lds);
#endif
        if (0 + 1 < hi) grid.sync(); }
#endif
#if !defined(PHASE_MASK) || ((PHASE_MASK >> 1) & 1)
    if (lo <= 1 && 1 < hi) { phase_inproj(p, lds);
#if defined(DUP_PHASE) && DUP_PHASE == 1
        grid.sync(); phase_inproj(p, lds);
#endif
        if (1 + 1 < hi) grid.sync(); }
#endif
#ifdef EXP_CANARY
    { u32x4* q = (u32x4*)(p.ws + OFF_Q); const size_t n = (size_t)192 * MiB / 16; u32x4 v; v.x = v.y = v.z = v.w = 0x7fc07fc0u;
      int t_ = threadIdx.x; asm volatile("" : "+v"(t_));
      for (size_t i = (size_t)blockIdx.x * 256 + t_; i < n; i += (size_t)gridDim.x * 256) q[i] = v; grid.sync(); }
#endif
#if !defined(PHASE_MASK) || ((PHASE_MASK >> 2) & 1)
    if (lo <= 2 && 2 < hi) { phase_up(p, lds);
#if defined(DUP_PHASE) && DUP_PHASE == 2
        grid.sync(); phase_up(p, lds);
#endif
        if (2 + 1 < hi) grid.sync(); }
#endif
#ifdef EXP_CANARY
    { u32x4* q = (u32x4*)(p.ws + OFF_O); const size_t n = (size_t)48 * MiB / 16; u32x4 v; v.x = v.y = v.z = v.w = 0x7fc07fc0u;
      int t_ = threadIdx.x; asm volatile("" : "+v"(t_));
      for (size_t i = (size_t)blockIdx.x * 256 + t_; i < n; i += (size_t)gridDim.x * 256) q[i] = v; grid.sync(); }
#endif
#if !defined(PHASE_MASK) || ((PHASE_MASK >> 3) & 1)
    if (lo <= 3 && 3 < hi) { phase_attn(p, lds);
#if defined(DUP_PHASE) && DUP_PHASE == 3
        grid.sync(); phase_attn(p, lds);
#endif
        if (3 + 1 < hi) grid.sync(); }
#endif
#if !defined(PHASE_MASK) || ((PHASE_MASK >> 4) & 1)
    if (lo <= 4 && 4 < hi) { phase_merge(p, lds);
#if defined(DUP_PHASE) && DUP_PHASE == 4
        grid.sync(); phase_merge(p, lds);
#endif
        if (4 + 1 < hi) grid.sync(); }
#endif
#if !defined(PHASE_MASK) || ((PHASE_MASK >> 5) & 1)
    if (lo <= 5 && 5 < hi) { phase_resgemm<0>(p, lds);
#if defined(DUP_PHASE) && DUP_PHASE == 5
        grid.sync(); phase_resgemm<0>(p, lds);
#endif
        if (5 + 1 < hi) grid.sync(); }
#endif
#if !defined(PHASE_MASK) || ((PHASE_MASK >> 6) & 1)
    if (lo <= 6 && 6 < hi) { phase_ln<0>(p);
#if defined(DUP_PHASE) && DUP_PHASE == 6
        grid.sync(); phase_ln<0>(p);
#endif
        if (6 + 1 < hi) grid.sync(); }
#endif
#if !defined(PHASE_MASK) || ((PHASE_MASK >> 7) & 1)
    if (lo <= 7 && 7 < hi) { phase_ffn_up(p, lds);
#if defined(DUP_PHASE) && DUP_PHASE == 7
        grid.sync(); phase_ffn_up(p, lds);
#endif
        if (7 + 1 < hi) grid.sync(); }
#endif
#if !defined(PHASE_MASK) || ((PHASE_MASK >> 8) & 1)
    if (lo <= 8 && 8 < hi) { phase_resgemm<1>(p, lds);
#if defined(DUP_PHASE) && DUP_PHASE == 8
        grid.sync(); phase_resgemm<1>(p, lds);
#endif
        if (8 + 1 < hi) grid.sync(); }
#endif
#if !defined(PHASE_MASK) || ((PHASE_MASK >> 9) & 1)
    if (lo <= 9 && 9 < hi) { phase_ln<1>(p);
#if defined(DUP_PHASE) && DUP_PHASE == 9
        grid.sync(); phase_ln<1>(p);
#endif
        if (9 + 1 < hi) grid.sync(); }
#endif
}

extern "C" void kernel_launch(void* const* d_in, const int* in_sizes, int n_in, void* d_out, int out_size, void* d_ws, size_t ws_size, hipStream_t stream) {
    static int grid_blocks = 0;
    if (!grid_blocks) {
        int dev = 0, cus = 0, per_cu = 0;
        hipGetDevice(&dev);
        hipDeviceGetAttribute(&cus, hipDeviceAttributeMultiprocessorCount, dev);
        hipOccupancyMaxActiveBlocksPerMultiprocessor(&per_cu, mega, 512, 0);
        if (per_cu < 1) per_cu = 1;
        if (per_cu > 1) per_cu = 1;
        grid_blocks = cus * per_cu;
        if (ws_size < WS_END) { fprintf(stderr, "kernel_launch: workspace too small: %zu < %zu\n", ws_size, (size_t)WS_END); grid_blocks = -1; }
    }
    if (grid_blocks < 0) return;
    Params p{};
    p.x_prompt = (const float*)d_in[0]; p.x_sample = (const float*)d_in[1]; p.w_in = (const float*)d_in[2]; p.w_fourier = (const float*)d_in[3];
    p.g_q = (const float*)d_in[4]; p.w_uq = (const float*)d_in[5]; p.g_kv = (const float*)d_in[6]; p.w_ukv = (const float*)d_in[7];
    p.w_attn = (const float*)d_in[8]; p.w_o = (const float*)d_in[9]; p.ln1_g = (const float*)d_in[10]; p.ln1_b = (const float*)d_in[11];
    p.w_gate = (const float*)d_in[12]; p.w_up = (const float*)d_in[13]; p.w_down = (const float*)d_in[14]; p.ln2_g = (const float*)d_in[15]; p.ln2_b = (const float*)d_in[16];
    p.out = (float*)d_out; p.ws = (unsigned char*)d_ws;
#if COOP
    p.ph_lo = 0; p.ph_hi = NPHASE;
    void* args[] = {&p};
    hipError_t e = hipLaunchCooperativeKernel((void*)mega, dim3(grid_blocks), dim3(512), args, 0, stream);
    if (e != hipSuccess) fprintf(stderr, "cooperative launch failed: %s (grid %d)\n", hipGetErrorString(e), grid_blocks);
#else
    for (int ph = 0; ph < NPHASE; ++ph) {
        p.ph_lo = ph; p.ph_hi = ph + 1;
        hipLaunchKernelGGL(mega, dim3(grid_blocks), dim3(512), 0, stream, p);
    }
#endif
}
```
